# Optimizing an MI355X kernel written in HIP

```python
import jax, jax.numpy as jnp
from jax import lax
import numpy as np

D_MODEL = 2048
BATCH = 2
SEQ = 8192
DEPTH = 2

HEAD_DIM = 128
MIX_WIDTH = D_MODEL
A_HEADS = MIX_WIDTH // 2 // HEAD_DIM
B_HEADS = MIX_WIDTH // 4 // HEAD_DIM
POOL_GROUPS = 4
POOL_GROUP_DIM = MIX_WIDTH // 4 // POOL_GROUPS
POOL_WINDOWS = (2, 4, 8, 16)
A_WIDTH = A_HEADS * HEAD_DIM
B_WIDTH = B_HEADS * HEAD_DIM
C_WIDTH = POOL_GROUPS * POOL_GROUP_DIM
IN_COLS = 3 * A_WIDTH + 3 * B_WIDTH + C_WIDTH
MOBA_BLOCK = 256
MOBA_TOPK = 3
MOBA_Q_CHUNK = 32
DIL_PAIRS = ((128, 1), (512, 4), (2048, 16))
MEM_LEN = 256
MEM_HEADS = 4
MEM_WIDTH = MEM_HEADS * HEAD_DIM
N_GROUPS = 4
EXPERTS_PER_GROUP = 8
EXPERT_FF = D_MODEL // 4
EXPERT_TOPK = 2
RMS_EPS = 1e-6

kernel_name = "hybrid_moba_dilated_pool_hmoe_trunk"


def rmsnorm(x, g):
    xf = x.astype(jnp.float32)
    y = xf * lax.rsqrt(jnp.mean(xf * xf, axis=-1, keepdims=True) + RMS_EPS)
    return (y * g.astype(jnp.float32)).astype(x.dtype)


def alibi_slopes():
    n = A_HEADS + B_HEADS
    s = 2.0 ** (-8.0 * np.arange(1, n + 1) / n)
    is_b = (np.arange(n) % 3) == 2
    return jnp.asarray(s[~is_b], jnp.float32), jnp.asarray(s[is_b], jnp.float32)


def to_heads(t, n_heads):
    b, s, _ = t.shape
    return t.reshape(b, s, n_heads, HEAD_DIM).transpose(0, 2, 1, 3)


def from_heads(t):
    b, h, s, d = t.shape
    return t.transpose(0, 2, 1, 3).reshape(b, s, h * d)


def moba_attention(q, k, v, slopes):
    b, h, s, dh = q.shape
    nblk = -(-s // MOBA_BLOCK)
    sp = nblk * MOBA_BLOCK
    pad = ((0, 0), (0, 0), (0, sp - s), (0, 0))
    q, k, v = jnp.pad(q, pad), jnp.pad(k, pad), jnp.pad(v, pad)
    kblocks = k.reshape(b, h, nblk, MOBA_BLOCK, dh)
    vblocks = v.reshape(b, h, nblk, MOBA_BLOCK, dh)
    kmean = jnp.mean(kblocks.astype(jnp.float32), axis=3)
    topk = min(MOBA_TOPK, nblk)
    scale = HEAD_DIM ** -0.5
    n_chunks = sp // MOBA_Q_CHUNK
    qc = q.reshape(b, h, n_chunks, MOBA_Q_CHUNK, dh).transpose(2, 0, 1, 3, 4)
    bi = jnp.arange(b)[:, None, None, None]
    hi = jnp.arange(h)[None, :, None, None]
    blk_ids = jnp.arange(nblk)
    offs = jnp.arange(MOBA_BLOCK)

    def chunk_fn(args):
        ci, qch = args
        start = ci * MOBA_Q_CHUNK
        own = start // MOBA_BLOCK
        tpos = start + jnp.arange(MOBA_Q_CHUNK)
        gate = jnp.einsum('bhqd,bhnd->bhqn', qch.astype(jnp.float32), kmean)
        gate = jnp.where((blk_ids < own)[None, None, None, :], gate, -jnp.inf)
        _, idx = lax.top_k(gate, topk)
        sel_valid = idx < own
        ksel = kblocks[bi, hi, idx]
        vsel = vblocks[bi, hi, idx]
        kown = lax.dynamic_index_in_dim(kblocks, own, axis=2, keepdims=False)
        vown = lax.dynamic_index_in_dim(vblocks, own, axis=2, keepdims=False)
        s_sel = jnp.einsum('bhqd,bhqjkd->bhqjk', qch, ksel).astype(jnp.float32) * scale
        dist_sel = (tpos[None, None, :, None, None] - (idx[..., None] * MOBA_BLOCK + offs)).astype(jnp.float32)
        s_sel = jnp.where(sel_valid[..., None],
                          s_sel - slopes[None, :, None, None, None] * dist_sel, -jnp.inf)
        s_own = jnp.einsum('bhqd,bhkd->bhqk', qch, kown).astype(jnp.float32) * scale
        dist_own = tpos[:, None] - (own * MOBA_BLOCK + offs)[None, :]
        s_own = jnp.where((dist_own >= 0)[None, None],
                          s_own - slopes[None, :, None, None] * dist_own.astype(jnp.float32)[None, None],
                          -jnp.inf)
        s_all = jnp.concatenate([s_sel.reshape(b, h, MOBA_Q_CHUNK, topk * MOBA_BLOCK), s_own], axis=-1)
        p = jax.nn.softmax(s_all, axis=-1).astype(v.dtype)
        p_sel = p[..., :topk * MOBA_BLOCK].reshape(b, h, MOBA_Q_CHUNK, topk, MOBA_BLOCK)
        p_own = p[..., topk * MOBA_BLOCK:]
        return (jnp.einsum('bhqjk,bhqjkd->bhqd', p_sel, vsel)
                + jnp.einsum('bhqk,bhkd->bhqd', p_own, vown))

    o = lax.map(chunk_fn, (jnp.arange(n_chunks), qc))
    o = o.transpose(1, 2, 0, 3, 4).reshape(b, h, sp, dh)
    return o[:, :, :s]


def dilated_branch(q, k, v, slopes, n_off, dil):
    b, h, sp, dh = q.shape
    L = sp // dil
    nb = L // n_off

    def split(t):
        return t.reshape(b, h, L, dil, dh).transpose(0, 1, 3, 2, 4).reshape(b, h, dil, nb, n_off, dh)

    def with_prev(t):
        prev = jnp.pad(t[:, :, :, :-1], ((0, 0), (0, 0), (0, 0), (1, 0), (0, 0), (0, 0)))
        return jnp.concatenate([prev, t], axis=4)

    qb = split(q)
    kk, vv = with_prev(split(k)), with_prev(split(v))
    s = jnp.einsum('bhrnqd,bhrnkd->bhrnqk', qb, kk).astype(jnp.float32) * (HEAD_DIM ** -0.5)
    qi = jnp.arange(n_off)[:, None]
    ki = jnp.arange(2 * n_off)[None, :]
    j = qi + n_off - ki
    blk = jnp.arange(nb)[:, None, None]
    valid = (j >= 0) & (j <= n_off) & ((blk > 0) | (ki >= n_off))
    penalty = slopes[None, :, None, None, None, None] * (j * dil).astype(jnp.float32)
    s = jnp.where(valid[None, None, None], s - penalty, -jnp.inf)
    lse = jax.nn.logsumexp(s, axis=-1)
    p = jnp.exp(s - lse[..., None]).astype(v.dtype)
    o = jnp.einsum('bhrnqk,bhrnkd->bhrnqd', p, vv)
    o = o.reshape(b, h, dil, L, dh).transpose(0, 1, 3, 2, 4).reshape(b, h, sp, dh)
    lse = lse.reshape(b, h, dil, L).transpose(0, 1, 3, 2).reshape(b, h, sp)
    return o, lse


def dilated_attention(q, k, v, slopes):
    b, h, s, dh = q.shape
    unit = max(d for _, d in DIL_PAIRS) * max(w // d for w, d in DIL_PAIRS)
    sp = -(-s // unit) * unit
    pad = ((0, 0), (0, 0), (0, sp - s), (0, 0))
    q, k, v = jnp.pad(q, pad), jnp.pad(k, pad), jnp.pad(v, pad)
    outs, lses = [], []
    for window, dil in DIL_PAIRS:
        o, lse = dilated_branch(q, k, v, slopes, window // dil, dil)
        outs.append(o)
        lses.append(lse)
    w = jax.nn.softmax(jnp.stack(lses), axis=0)
    o = jnp.einsum('gbhs,gbhsd->bhsd', w, jnp.stack(outs).astype(jnp.float32))
    return o[:, :, :s].astype(q.dtype)


def pool_mixer(u, w_pool, scale):
    b, s, _ = u.shape
    ug = u.reshape(b, s, POOL_GROUPS, POOL_GROUP_DIM).astype(jnp.float32)
    cs = jnp.concatenate([jnp.zeros((b, 1, POOL_GROUPS, POOL_GROUP_DIM), jnp.float32),
                          jnp.cumsum(ug, axis=1)], axis=1)
    t = jnp.arange(s)[:, None]
    win = jnp.asarray(POOL_WINDOWS)[None, :]
    lo = jnp.maximum(t + 1 - win, 0)
    cnt = (t + 1 - lo).astype(jnp.float32)
    cs_lo = cs[:, lo, jnp.arange(POOL_GROUPS)[None, :]]
    mean = (cs[:, 1:] - cs_lo) / cnt[None, :, :, None]
    pooled = (mean - ug).astype(u.dtype)
    y = jnp.einsum('bsgc,gcd->bsgd', pooled, w_pool) * scale.reshape(POOL_GROUPS, POOL_GROUP_DIM)
    return y.reshape(b, s, C_WIDTH)


def memory_cross_attention(h, mem, g_memkv, w_mq, w_mk, w_mv, w_mo):
    b, s, _ = h.shape
    mn = rmsnorm(mem, g_memkv)
    q = (h @ w_mq).reshape(b, s, MEM_HEADS, HEAD_DIM)
    k = (mn @ w_mk).reshape(b, -1, MEM_HEADS, HEAD_DIM)
    v = (mn @ w_mv).reshape(b, -1, MEM_HEADS, HEAD_DIM)
    sc = jnp.einsum('bshd,bmhd->bhsm', q, k).astype(jnp.float32) * (HEAD_DIM ** -0.5)
    p = jax.nn.softmax(sc, axis=-1).astype(v.dtype)
    o = jnp.einsum('bhsm,bmhd->bshd', p, v).reshape(b, s, MEM_WIDTH)
    return o @ w_mo


def hier_moe(h, w_group, b_group, w_router, b_router, w1, w3, w2):
    b, s, d = h.shape
    xt = h.reshape(b * s, d)
    glog = (xt @ w_group).astype(jnp.float32) + b_group.astype(jnp.float32)
    gprob = jax.nn.softmax(glog, axis=-1)
    gsel = jnp.argmax(glog, axis=-1)
    gw = jnp.take_along_axis(gprob, gsel[:, None], axis=1)[:, 0]
    elog_all = jnp.einsum('td,gde->tge', xt, w_router).astype(jnp.float32) + b_router.astype(jnp.float32)
    elog = jnp.take_along_axis(elog_all, gsel[:, None, None], axis=1)[:, 0]
    top_v, top_i = lax.top_k(elog, EXPERT_TOPK)
    ew = jax.nn.softmax(top_v, axis=-1) * gw[:, None]
    e_dense = jnp.sum(jax.nn.one_hot(top_i, EXPERTS_PER_GROUP, dtype=jnp.float32) * ew[..., None], axis=1)
    combine = (jax.nn.one_hot(gsel, N_GROUPS, dtype=jnp.float32)[:, :, None] * e_dense[:, None, :]).astype(h.dtype)
    y = jnp.zeros((b * s, d), h.dtype)
    for g in range(N_GROUPS):
        a = jnp.einsum('td,edf->tef', xt, w1[g])
        c = jnp.einsum('td,edf->tef', xt, w3[g])
        hid = jax.nn.silu(a) * c * combine[:, g, :, None]
        y = y + jnp.einsum('tef,efd->td', hid, w2[g])
    return y.reshape(b, s, d)


def setup_inputs(seed: int = 0) -> dict:
    key = jax.random.key(seed)
    ks = jax.random.split(key, 24)
    f32 = jnp.float32
    L, D, G, E, F = DEPTH, D_MODEL, N_GROUPS, EXPERTS_PER_GROUP, EXPERT_FF

    def nrm(k, shape, fan_in):
        return jax.random.normal(k, shape, f32) * (fan_in ** -0.5)

    def gain(k, shape):
        return 1.0 + 0.02 * jax.random.normal(k, shape, f32)

    return {
        "x": jax.random.normal(ks[0], (BATCH, SEQ, D), f32),
        "mem": jax.random.normal(ks[1], (BATCH, MEM_LEN, D), f32),
        "g_mix": gain(ks[2], (L, D)),
        "w_in": nrm(ks[3], (L, D, IN_COLS), D),
        "w_out": nrm(ks[4], (L, MIX_WIDTH, D), MIX_WIDTH),
        "pool_w": nrm(ks[5], (L, POOL_GROUPS, POOL_GROUP_DIM, POOL_GROUP_DIM), POOL_GROUP_DIM),
        "pool_scale": gain(ks[6], (L, C_WIDTH)),
        "g_mem": gain(ks[7], (L, D)),
        "g_memkv": gain(ks[8], (L, D)),
        "w_mq": nrm(ks[9], (L, D, MEM_WIDTH), D),
        "w_mk": nrm(ks[10], (L, D, MEM_WIDTH), D),
        "w_mv": nrm(ks[11], (L, D, MEM_WIDTH), D),
        "w_mo": nrm(ks[12], (L, MEM_WIDTH, D), MEM_WIDTH),
        "g_ffn": gain(ks[13], (L, D)),
        "w_group": nrm(ks[14], (L, D, G), D),
        "b_group": 0.01 * jax.random.normal(ks[15], (L, G), f32),
        "w_router": nrm(ks[16], (L, G, D, E), D),
        "b_router": 0.01 * jax.random.normal(ks[17], (L, G, E), f32),
        "w1": nrm(ks[18], (L, G, E, D, F), D),
        "w3": nrm(ks[19], (L, G, E, D, F), D),
        "w2": nrm(ks[20], (L, G, E, F, D), F),
        "g_final": gain(ks[21], (D,)),
    }


def reference(x, mem, g_mix, w_in, w_out, pool_w, pool_scale, g_mem, g_memkv, w_mq, w_mk, w_mv,
              w_mo, g_ffn, w_group, b_group, w_router, b_router, w1, w3, w2, g_final):
    slopes_a, slopes_b = alibi_slopes()
    splits = [A_WIDTH, 2 * A_WIDTH, 3 * A_WIDTH, 3 * A_WIDTH + B_WIDTH,
              3 * A_WIDTH + 2 * B_WIDTH, 3 * A_WIDTH + 3 * B_WIDTH]
    for l in range(DEPTH):
        h = rmsnorm(x, g_mix[l])
        proj = h @ w_in[l]
        qa, ka, va, qb, kb, vb, u = jnp.split(proj, splits, axis=-1)
        oa = from_heads(moba_attention(to_heads(qa, A_HEADS), to_heads(ka, A_HEADS),
                                       to_heads(va, A_HEADS), slopes_a))
        ob = from_heads(dilated_attention(to_heads(qb, B_HEADS), to_heads(kb, B_HEADS),
                                          to_heads(vb, B_HEADS), slopes_b))
        oc = pool_mixer(u, pool_w[l], pool_scale[l])
        x = x + jnp.concatenate([oa, ob, oc], axis=-1) @ w_out[l]
        x = x + memory_cross_attention(rmsnorm(x, g_mem[l]), mem, g_memkv[l], w_mq[l], w_mk[l],
                                       w_mv[l], w_mo[l])
        x = x + hier_moe(rmsnorm(x, g_ffn[l]), w_group[l], b_group[l], w_router[l], b_router[l],
                         w1[l], w3[l], w2[l])
    return rmsnorm(x, g_final)
```

```cpp
#include <hip/hip_runtime.h>
#include <cstdio>
#include <cstdint>

#ifndef MK_LAUNCH_PER_PHASE
#define MK_LAUNCH_PER_PHASE 0
#endif

#define LAS __attribute__((address_space(3)))
#define GAS __attribute__((address_space(1)))

typedef unsigned short bf16_t;
typedef short bf16x8 __attribute__((ext_vector_type(8)));
typedef float f32x4 __attribute__((ext_vector_type(4)));
typedef float f32x2 __attribute__((ext_vector_type(2)));
typedef unsigned u32x4 __attribute__((ext_vector_type(4)));
typedef unsigned u32x2 __attribute__((ext_vector_type(2)));
typedef int i32x4 __attribute__((ext_vector_type(4)));
typedef int i32x8 __attribute__((ext_vector_type(8)));

constexpr int T = 16384, D = 2048, SEQ = 8192, INC = 5120;
constexpr int NTOK_ALL = T + 512;
constexpr int MAXROWS = 40960;
constexpr float RMS_EPS = 1e-6f;
constexpr float ATT_SCALE = 0.08838834764831845f;

constexpr size_t MiB = 1u << 20;
constexpr size_t WS_CTL = 0, CTL_ZERO_BYTES = 160 * 1024;
constexpr size_t WS_XRES = 1 * MiB;
constexpr size_t WS_X8 = WS_XRES;
constexpr size_t WS_XI8 = WS_XRES + 32 * MiB;
constexpr size_t WS_WIN8 = WS_XRES + 64 * MiB;
constexpr size_t WS_XB = WS_XRES + 128 * MiB;
constexpr size_t WS_SMALL = WS_XB + 66 * MiB;
constexpr size_t WS_P = WS_SMALL + 32 * MiB;
constexpr size_t WS_MIX = WS_P + 160 * MiB;
constexpr size_t WS_QC = WS_MIX + 64 * MiB;
constexpr size_t WS_OC = WS_QC + 16 * MiB;
constexpr size_t WS_KVC = WS_OC + 16 * MiB;
constexpr size_t WS_H = WS_KVC + 2 * MiB;
constexpr size_t WS_WIN = WS_H + 40 * MiB;
constexpr size_t WS_WOUT = WS_WIN + 40 * MiB;
constexpr size_t WS_WC = WS_WOUT + 16 * MiB;
constexpr size_t WS_WMO = WS_WC + 12 * MiB;
constexpr size_t WS_W13 = WS_WMO + 4 * MiB;
constexpr size_t WS_W2 = WS_W13 + 128 * MiB;
constexpr size_t WS_OP = WS_W2 + 64 * MiB;
constexpr size_t WS_END = WS_OP + 192 * MiB;
constexpr size_t SM_RSALL = 0;
constexpr size_t SM_SSQP = 128 * 1024;
constexpr size_t SM_KMEAN = SM_SSQP + 2 * MiB;
constexpr size_t SM_SEL = SM_KMEAN + 256 * 1024;
constexpr size_t SM_TOKE = SM_SEL + 2 * MiB;
constexpr size_t SM_TOKRANK = SM_TOKE + 128 * 1024;
constexpr size_t SM_TOKW = SM_TOKRANK + 128 * 1024;
constexpr size_t SM_RS3 = SM_TOKW + 128 * 1024;
constexpr size_t SM_TOKROW = SM_RS3 + 64 * 1024;
constexpr size_t SM_ROWINFO = SM_TOKROW + 128 * 1024;
constexpr size_t SM_PANEL = SM_ROWINFO + 640 * 1024;
constexpr size_t SM_ML = 6 * MiB;
constexpr size_t SM_LIST = 12 * MiB;
constexpr size_t SM_ROWTOK = 5 * MiB + 768 * 1024;
constexpr size_t SM_WRT = 28 * MiB;
constexpr size_t SM_KMH = 29 * MiB;
static_assert((size_t)(4096 + 3456) * 4 <= 64 * 1024, "control words inside the per-call memset");
static_assert(SM_PANEL + 4096 <= SM_ROWTOK && SM_ROWTOK + 4 * MAXROWS <= SM_ML && SM_LIST + 16 * MiB <= 32 * MiB, "small tables");
constexpr int CPAD = 32;
constexpr int CW_CNT = 1024;
constexpr int CW_LCNT = 8192;
constexpr int CW_BAR = 4096;

constexpr int RING_BYTES = 131072;
constexpr int MISC_OFF = RING_BYTES;
constexpr int LDS_BYTES = 147456;

__device__ __forceinline__ unsigned f2bf(float f) { unsigned u = __builtin_bit_cast(unsigned, f); return (u + 0x7fffu + ((u >> 16) & 1u)) >> 16; }
__device__ __forceinline__ unsigned pk2(float lo, float hi) { unsigned r; asm("v_cvt_pk_bf16_f32 %0, %1, %2" : "=v"(r) : "v"(lo), "v"(hi)); return r; }
constexpr float H8_SCALE = 8.0f, W28_SCALE = 256.0f;
constexpr float X8_SCALE = 16.0f, W8_SCALE = 512.0f;
__device__ __forceinline__ float clamp8(float v) { return __builtin_fminf(__builtin_fmaxf(v, -448.0f), 448.0f); }
__device__ __forceinline__ unsigned pk4f8(f32x4 v) { int r = 0; r = __builtin_amdgcn_cvt_pk_fp8_f32(clamp8(v[0]), clamp8(v[1]), r, false); r = __builtin_amdgcn_cvt_pk_fp8_f32(clamp8(v[2]), clamp8(v[3]), r, true); return (unsigned)r; }
__device__ __forceinline__ float bf_lo(unsigned u) { return __builtin_bit_cast(float, u << 16); }
__device__ __forceinline__ float bf_hi(unsigned u) { return __builtin_bit_cast(float, u & 0xffff0000u); }
__device__ __forceinline__ float wave_sum(float v) {
#pragma unroll
    for (int o = 1; o < 64; o <<= 1) v += __shfl_xor(v, o);
    return v;
}
#define LDS_WAIT() asm volatile("s_waitcnt lgkmcnt(0)" ::: "memory")

#define XB_TMO      128
#define XB_XCNT(j)  (256  + 64 * (j))
#define XB_XSUB(j)  (1280 + 64 * (j))
#define XB_XGEN(j)  (2304 + 64 * (j))
#define XB_TOP      3328
#define XB_TOPGEN   3392
#define XCD_BAR_WORDS 3456
#define XB_SPIN_CAP (1u << 22)

__device__ __forceinline__ unsigned xb_ld(unsigned* p)              { return __hip_atomic_load(p, __ATOMIC_RELAXED, __HIP_MEMORY_SCOPE_AGENT); }
__device__ __forceinline__ unsigned xb_add(unsigned* p, unsigned v) { return __hip_atomic_fetch_add(p, v, __ATOMIC_RELAXED, __HIP_MEMORY_SCOPE_AGENT); }
__device__ __forceinline__ unsigned xb_xcc_id() { return (unsigned)__builtin_amdgcn_s_getreg((3 << 11) | 20) & 0xFu; }
#define XB_SPIN(cond, bar) do { unsigned _sp = 0; while (cond) { __builtin_amdgcn_s_sleep(1); \
    if ((++_sp & 255u) == 0u) { if (xb_ld(&(bar)[XB_TMO])) break; if (_sp > XB_SPIN_CAP) { atomicAdd(&(bar)[XB_TMO], 1u); break; } } } } while (0)

struct XcdBarrier { unsigned* bar; unsigned x; volatile LAS unsigned* st; };

__device__ __forceinline__ XcdBarrier xcd_barrier_post(unsigned* bar, volatile LAS unsigned* st) {
    XcdBarrier b; b.bar = bar; b.x = xb_xcc_id(); b.st = st;
    if (threadIdx.x == 0) (void)xb_add(&bar[XB_XCNT(b.x)], 1u);
    return b;
}
__device__ __forceinline__ void xcd_barrier_complete(unsigned* bar, unsigned x, unsigned& nloc, unsigned& nx) {
    const unsigned G = gridDim.x * gridDim.y * gridDim.z;
    unsigned sum, cnt, mine, sp = 0u;
    for (;;) {
        sum = 0u; cnt = 0u; mine = 0u;
#pragma unroll
        for (unsigned j = 0; j < 16; ++j) { const unsigned c = xb_ld(&bar[XB_XCNT(j)]); sum += c; cnt += (c > 0u) ? 1u : 0u; mine = (j == x) ? c : mine; }
        if (sum == G) break;
        __builtin_amdgcn_s_sleep(1);
        if ((++sp & 255u) == 0u) { if (xb_ld(&bar[XB_TMO])) break; if (sp > XB_SPIN_CAP) { atomicAdd(&bar[XB_TMO], 1u); break; } }
    }
    nloc = mine > 0u ? mine : 1u; nx = cnt > 0u ? cnt : 1u;
}
__device__ __forceinline__ void xcd_barrier(const XcdBarrier& b) {
    asm volatile("s_waitcnt vmcnt(0)" ::: "memory");
    __syncthreads();
    if (threadIdx.x == 0) {
        unsigned* bar = b.bar;
        __builtin_amdgcn_s_waitcnt(0);
        unsigned nloc = b.st[0], nx = b.st[1];
        if (nloc == 0u) { xcd_barrier_complete(bar, b.x, nloc, nx); b.st[0] = nloc; b.st[1] = nx; }
        const unsigned old = xb_add(&bar[XB_XSUB(b.x)], 1u);
        const unsigned gen = old / nloc;
        if (old + 1u == (gen + 1u) * nloc) {
            __builtin_amdgcn_fence(__ATOMIC_RELEASE, "agent");
            asm volatile("s_waitcnt vmcnt(0)" ::: "memory");
            const unsigned og = xb_add(&bar[XB_TOP], 1u);
            const unsigned tg = og / nx;
            if (og + 1u == (tg + 1u) * nx) xb_add(&bar[XB_TOPGEN], 1u);
            else XB_SPIN(xb_ld(&bar[XB_TOPGEN]) == tg, bar);
            __builtin_amdgcn_fence(__ATOMIC_ACQUIRE, "agent");
            xb_add(&bar[XB_XGEN(b.x)], 1u);
            asm volatile("s_waitcnt vmcnt(0)" ::: "memory");
        } else {
            XB_SPIN(xb_ld(&bar[XB_XGEN(b.x)]) == gen, bar);
            __builtin_amdgcn_fence(__ATOMIC_ACQUIRE, "agent");
            asm volatile("s_waitcnt vmcnt(0)" ::: "memory");
        }
    }
    __syncthreads();
}

namespace pg8 {
constexpr int BM = 256, BK = 64, HALF = 128, HTB = HALF * BK * 2, STAGE_BYTES = 8 * HTB, NXCD = 8, WGM = 8;
__host__ __device__ __forceinline__ int lds_byte(int r, int c) { const int st = (r >> 4) * 2 + (c >> 5), rr = r & 15, cc = c & 31, ob = rr * 64 + cc * 2; return st * 1024 + (ob ^ (((ob >> 9) & 1) << 5)); }
__host__ __device__ __forceinline__ void stage_rc(int b, int& R, int& C) { const int st = b / 1024, sb = b % 1024, swz = sb ^ (((sb >> 9) & 1) << 5); R = (st >> 1) * 16 + swz / 64; C = (st & 1) * 32 + (swz % 64) / 2; }
__host__ __device__ __forceinline__ int perm32(int rho) { const int n = rho >> 4, i = rho & 15; return 8 * (i >> 2) + 4 * n + (i & 3); }

__device__ __forceinline__ i32x8 cat8(bf16x8 a, bf16x8 b) { const i32x4 x = __builtin_bit_cast(i32x4, a), y = __builtin_bit_cast(i32x4, b); return __builtin_shufflevector(x, y, 0, 1, 2, 3, 4, 5, 6, 7); }
__device__ __forceinline__ void mfma8(f32x4& c, i32x8 a, i32x8 b) { asm volatile("v_mfma_f32_16x16x128_f8f6f4 %0, %1, %2, %0" : "+v"(c) : "v"(a), "v"(b)); }
#define MFMA_DRAIN() asm volatile("s_nop 15\n\ts_nop 15" ::: "memory")
struct Unit { int pm, pn; };
struct Gemm { const bf16_t* A; const bf16_t* Bt; int M, N, K; };

struct StaticOrder {
    int nM, nN, nwg, G, c;
    __device__ void init(int M, int N, int G_, int c_) { nM = M / BM; nN = N / BM; nwg = nM * nN; G = G_; c = c_; }
    __device__ bool next(int i, Unit& u) const {
        const long L = (long)i * G + c; if (L >= nwg) return false;
        int wgid = (int)L; { const int q = nwg / NXCD, r = nwg % NXCD, xcd = wgid % NXCD, off = wgid / NXCD; wgid = (xcd < r ? xcd * (q + 1) : r * (q + 1) + (xcd - r) * q) + off; }
        const int nig = WGM * nN, gid = wgid / nig, fm = gid * WGM, gsz = (nM - fm) < WGM ? (nM - fm) : WGM;
        u.pm = fm + ((wgid % nig) % gsz); u.pn = (wgid % nig) / gsz; return true;
    }
    __device__ __forceinline__ void a_ready(const Unit&) const {}
    __device__ __forceinline__ void done(const Unit&) const {}
};
struct SubsetOrder {
    StaticOrder so; int l0, b0, l1, b1, b2;
    __device__ bool next(int i, Unit& u) const { if (!so.next(i, u)) return false; const int j = u.pn; u.pn = j < l0 ? b0 + j : j < l0 + l1 ? b1 + (j - l0) : b2 + (j - l0 - l1); return true; }
    __device__ __forceinline__ void a_ready(const Unit&) const {}
    __device__ __forceinline__ void done(const Unit&) const {}
};
struct P7Order {
    int G, c, nq, nextra;
    __device__ bool next(int i, Unit& u) const {
        const int L = i * G + c;
        if (L < nq) { if (i == 0 && (nq & 15) == 0 && nq <= G && (G & 7) == 0 && ((G - nq) & 7) == 0) { const int x = c & 7, j = c >> 3, ppx = nq >> 4; u.pm = x * ppx + (j >> 1); u.pn = j & 1; }
                      else { u.pm = L >> 1; u.pn = L & 1; } return true; }
        const int j = L - nq; if (j >= nextra) return false;
        u.pm = 64 + (j & 1); u.pn = 2 + (j >> 1); return true;
    }
    __device__ __forceinline__ void a_ready(const Unit&) const {}
    __device__ __forceinline__ void done(const Unit&) const {}
};
struct GroupedOrder {
    int G, c, nct; const int* panel_e; int p0, npanels;
    __device__ bool next(int i, Unit& u) const {
        const int L = (G & 7) == 0 ? i * G + (c & 7) * (G >> 3) + (c >> 3) : i * G + c; if (L >= npanels * nct) return false;
        const int p = p0 + L / nct, ct = L % nct; u.pm = p; u.pn = __builtin_amdgcn_readfirstlane(panel_e[p]) * nct + ct; return true;
    }
    __device__ __forceinline__ void a_ready(const Unit&) const {}
    __device__ __forceinline__ void done(const Unit&) const {}
};
struct OneUnitOrder {
    int c, nct; const int* panel_e; int p0, nunits;
    __device__ bool next(int i, Unit& u) const {
        if (i != 0 || c >= nunits) return false;
        const int p = p0 + c / nct, ct = c % nct; u.pm = p; u.pn = __builtin_amdgcn_readfirstlane(panel_e[p]) * nct + ct; return true;
    }
    __device__ __forceinline__ void a_ready(const Unit&) const {}
    __device__ __forceinline__ void done(const Unit&) const {}
};
struct GroupedSkewOrder {
    int G, c, nct; const int* panel_e; int npanels, nlong, skip;
    __device__ bool next(int i, Unit& u) const {
        const int S = G - nlong; int L;
        if ((G & 7) == 0 && (nlong & 7) == 0) {
            const int x = c & 7, j = c >> 3, jl = (c - nlong) >> 3;
            if (c >= nlong) L = (i < skip) ? i * S + x * (S >> 3) + jl : skip * S + (i - skip) * G + x * (G >> 3) + j; else L = skip * S + i * G + x * (G >> 3) + j;
        } else if (c >= nlong) L = (i < skip) ? i * S + (c - nlong) : skip * S + (i - skip) * G + c; else L = skip * S + i * G + c;
        if (L >= npanels * nct) return false;
        const int p = L / nct, ct = L % nct; u.pm = p; u.pn = __builtin_amdgcn_readfirstlane(panel_e[p]) * nct + ct; return true;
    }
    __device__ __forceinline__ void a_ready(const Unit&) const {}
    __device__ __forceinline__ void done(const Unit&) const {}
};

struct EpiScaleBf16 {
    static constexpr bool PERM = true, AFTER_DRAIN = false;
    bf16_t* O; int ldc; const float* rs; float* kpart; float dq;
    __device__ __forceinline__ void operator()(const f32x4 (&acc)[2][2][4][2], const Unit& u, int wr, int wc, int fr, int fq) const {
        const int row0 = u.pm * BM + wr * 64 + fr, col0 = u.pn * BM + wc * 32 + 8 * fq;
        const bool ksum = kpart != nullptr && u.pn >= 4 && u.pn < 8;
        f32x4 cs[2][2];
#pragma unroll
        for (int bj = 0; bj < 2; ++bj) { cs[bj][0] = (f32x4){0.f, 0.f, 0.f, 0.f}; cs[bj][1] = (f32x4){0.f, 0.f, 0.f, 0.f}; }
#pragma unroll
        for (int ai = 0; ai < 2; ++ai)
#pragma unroll
            for (int m = 0; m < 4; ++m) { const int row = row0 + ai * HALF + m * 16; const float s = rs[row] * dq; bf16_t* rowp = O + (size_t)row * ldc + col0;
#pragma unroll
                for (int bj = 0; bj < 2; ++bj) { const f32x4 v0 = acc[ai][bj][m][0] * s, v1 = acc[ai][bj][m][1] * s;
                    cs[bj][0] += v0; cs[bj][1] += v1;
                    u32x4 w; w.x = pk2(v0[0], v0[1]); w.y = pk2(v0[2], v0[3]); w.z = pk2(v1[0], v1[1]); w.w = pk2(v1[2], v1[3]);
                    *(u32x4*)(rowp + bj * HALF) = w; } }
        if (ksum) {
#pragma unroll
            for (int bj = 0; bj < 2; ++bj)
#pragma unroll
                for (int n = 0; n < 2; ++n)
#pragma unroll
                    for (int j = 0; j < 4; ++j) { float v = cs[bj][n][j]; v += __shfl_xor(v, 1); v += __shfl_xor(v, 2); v += __shfl_xor(v, 4); v += __shfl_xor(v, 8); cs[bj][n][j] = v; }
            if (fr == 0) { float* kp = kpart + (size_t)(wr * 64 + u.pm) * 1024 + (col0 - 1024);
#pragma unroll
                for (int bj = 0; bj < 2; ++bj) { *(f32x4*)(kp + bj * HALF) = cs[bj][0]; *(f32x4*)(kp + bj * HALF + 4) = cs[bj][1]; } }
        }
    }
};
struct EpiP7 {
    static constexpr bool PERM = true, AFTER_DRAIN = false;
    bf16_t* qc; bf16_t* kvc; const float* rs_all;
    __device__ __forceinline__ void operator()(const f32x4 (&acc)[2][2][4][2], const Unit& u, int wr, int wc, int fr, int fq) const {
        const bool isq = u.pm < 64;
        const int lrow0 = wr * 64 + fr, cofs = wc * 32 + 8 * fq;
        const int j = u.pn - 2;
#pragma unroll
        for (int ai = 0; ai < 2; ++ai)
#pragma unroll
            for (int m = 0; m < 4; ++m) { const int lrow = lrow0 + ai * HALF + m * 16;
                float s = 1.0f; bf16_t* rowp;
                if (isq) { rowp = qc + (size_t)(u.pm * BM + lrow) * 512 + u.pn * BM + cofs; }
                else { const int r = (u.pm - 64) * BM + lrow; s = rs_all[T + r]; rowp = kvc + (size_t)(j >> 2) * 512 * 1024 + (size_t)r * 1024 + (j & 3) * BM + cofs; }
#pragma unroll
                for (int bj = 0; bj < 2; ++bj) { const f32x4 v0 = acc[ai][bj][m][0] * s, v1 = acc[ai][bj][m][1] * s;
                    u32x4 w; w.x = pk2(v0[0], v0[1]); w.y = pk2(v0[2], v0[3]); w.z = pk2(v1[0], v1[1]); w.w = pk2(v1[2], v1[3]);
                    *(u32x4*)(rowp + bj * HALF) = w; } }
    }
};
struct EpiRes {
    static constexpr bool PERM = true, AFTER_DRAIN = false;
    bf16_t* xb; float* ssqp; unsigned char* x8;
    __device__ __forceinline__ void operator()(const f32x4 (&acc)[2][2][4][2], const Unit& u, int wr, int wc, int fr, int fq) const {
        const int row0 = u.pm * BM + wr * 64 + fr, col0 = u.pn * BM + wc * 32 + 8 * fq;
#pragma unroll
        for (int ai = 0; ai < 2; ++ai) {
            u32x4 xo[4][2];
#pragma unroll
            for (int m = 0; m < 4; ++m)
#pragma unroll
                for (int bj = 0; bj < 2; ++bj) xo[m][bj] = *(const u32x4*)(xb + (size_t)(row0 + ai * HALF + m * 16) * D + col0 + bj * HALF);
            asm volatile("" ::: "memory");
#pragma unroll
            for (int m = 0; m < 4; ++m) { const int row = row0 + ai * HALF + m * 16; float ss = 0.f;
#pragma unroll
                for (int bj = 0; bj < 2; ++bj) { const u32x4 xv = xo[m][bj];
                    const f32x4 v0 = acc[ai][bj][m][0] + (f32x4){bf_lo(xv.x), bf_hi(xv.x), bf_lo(xv.y), bf_hi(xv.y)};
                    const f32x4 v1 = acc[ai][bj][m][1] + (f32x4){bf_lo(xv.z), bf_hi(xv.z), bf_lo(xv.w), bf_hi(xv.w)};
                    ss += ((v0[0] * v0[0] + v0[1] * v0[1]) + (v0[2] * v0[2] + v0[3] * v0[3])) + ((v1[0] * v1[0] + v1[1] * v1[1]) + (v1[2] * v1[2] + v1[3] * v1[3]));
                    u32x4 w; w.x = pk2(v0[0], v0[1]); w.y = pk2(v0[2], v0[3]); w.z = pk2(v1[0], v1[1]); w.w = pk2(v1[2], v1[3]);
                    *(u32x4*)(xb + (size_t)row * D + col0 + bj * HALF) = w;
                    if (x8) { u32x2 q; q.x = pk4f8(v0 * X8_SCALE); q.y = pk4f8(v1 * X8_SCALE); *(u32x2*)(x8 + (size_t)row * D + col0 + bj * HALF) = q; } }
                ss += __shfl_xor(ss, 16); ss += __shfl_xor(ss, 32);
                if (fq == 0) ssqp[(size_t)row * 32 + u.pn * 4 + wc] = ss; }
            asm volatile("" ::: "memory");
        }
    }
};
struct EpiMoe1 {
    static constexpr bool PERM = true, AFTER_DRAIN = false;
    unsigned char* H; const f32x4* rowinfo; float dq;
    __device__ __forceinline__ void operator()(const f32x4 (&acc)[2][2][4][2], const Unit& u, int wr, int wc, int fr, int fq) const {
        const int row0 = u.pm * BM + wr * 64 + fr, col0 = (u.pn & 3) * HALF + wc * 32 + 8 * fq;
#pragma unroll
        for (int ai = 0; ai < 2; ++ai)
#pragma unroll
            for (int m = 0; m < 4; ++m) { const int row = row0 + ai * HALF + m * 16; const f32x4 info = rowinfo[row]; const float rs = info[2] * dq, ew = info[1] * H8_SCALE;
                float h[8];
#pragma unroll
                for (int n = 0; n < 2; ++n)
#pragma unroll
                    for (int q = 0; q < 4; ++q) { const float a = acc[ai][0][m][n][q] * rs, c = acc[ai][1][m][n][q] * rs;
                        const float sg = __builtin_amdgcn_rcpf(1.0f + __expf(-a)); h[n * 4 + q] = a * sg * c * ew; }
                u32x2 w; w.x = pk4f8((f32x4){h[0], h[1], h[2], h[3]}); w.y = pk4f8((f32x4){h[4], h[5], h[6], h[7]});
                *(u32x2*)(H + (size_t)row * 512 + col0) = w; }
    }
};
struct EpiMoe2 {
    static constexpr bool PERM = true, AFTER_DRAIN = false;
    bf16_t* Y; float dq;
    __device__ __forceinline__ void operator()(const f32x4 (&acc)[2][2][4][2], const Unit& u, int wr, int wc, int fr, int fq) const {
        const int row0 = u.pm * BM + wr * 64 + fr, col0 = (u.pn & 7) * BM + wc * 32 + 8 * fq;
#pragma unroll
        for (int ai = 0; ai < 2; ++ai)
#pragma unroll
            for (int m = 0; m < 4; ++m) { bf16_t* rowp = Y + (size_t)(row0 + ai * HALF + m * 16) * D + col0;
#pragma unroll
                for (int bj = 0; bj < 2; ++bj) { const f32x4 v0 = acc[ai][bj][m][0] * dq, v1 = acc[ai][bj][m][1] * dq;
                    u32x4 w; w.x = pk2(v0[0], v0[1]); w.y = pk2(v0[2], v0[3]); w.z = pk2(v1[0], v1[1]); w.w = pk2(v1[2], v1[3]);
                    *(u32x4*)(rowp + bj * HALF) = w; } }
    }
};

template <class Epi, class Sched, bool F8 = false>
__device__ __forceinline__ void gemm_phase(LAS unsigned char* lds, const Gemm g, const Sched& S, const Epi& E) {
    int tid = threadIdx.x; asm volatile("" : "+v"(tid));
    const int wid = __builtin_amdgcn_readfirstlane(tid >> 6), lane = tid & 63, wr = wid >> 2, wc = wid & 3, fr = lane & 15, fq = lane >> 4;
    const int K = g.K, nt = K / BK;
    unsigned voffA[2], voffB[2];
#pragma unroll
    for (int i = 0; i < 2; ++i) { int R, C; stage_rc(tid * 16 + i * 8192, R, C); const int Rb = Epi::PERM ? ((R & ~31) + perm32(R & 31)) : R;
        voffA[i] = (unsigned)(R * K + C) * 2u; voffB[i] = (unsigned)(Rb * K + C) * 2u; }
    const size_t kstep = (size_t)(BK * 2);
    const size_t hstep = (size_t)HALF * K * 2;
    const size_t tstep = 2 * hstep;
    const unsigned ldsw = (unsigned)wid * 1024u;
    const int aoff = lds_byte(wr * 64 + fr, fq * 8), boff = lds_byte(wc * 32 + fr, fq * 8);
#define PG8_SA(b, h) (((b) * 2 + (h)) * HTB)
#define PG8_SB(b, h) ((4 + (b) * 2 + (h)) * HTB)
#define PG8_STAGE(bufoff, gbase, voff) do { _Pragma("unroll") for (int _i = 0; _i < 2; ++_i) \
        __builtin_amdgcn_global_load_lds((const unsigned*)((const char*)(gbase) + (voff)[_i]), (LAS unsigned*)(lds + (bufoff) + ldsw + _i * 8192), 16, 0, 0); } while (0)
#define PG8_LDA(dst, b, h) do { _Pragma("unroll") for (int m = 0; m < 4; ++m) _Pragma("unroll") for (int k = 0; k < 2; ++k) dst[m][k] = *(const LAS bf16x8*)(lds + PG8_SA(b, h) + aoff + m * 2048 + k * 1024); } while (0)
#define PG8_LDB(dst, b, h) do { _Pragma("unroll") for (int n = 0; n < 2; ++n) _Pragma("unroll") for (int k = 0; k < 2; ++k) dst[n][k] = *(const LAS bf16x8*)(lds + PG8_SB(b, h) + boff + n * 2048 + k * 1024); } while (0)
#define PG8_MMA(ai, bj, At, Bt) do { __builtin_amdgcn_s_setprio(1); _Pragma("unroll") for (int m = 0; m < 4; ++m) _Pragma("unroll") for (int n = 0; n < 2; ++n) { \
        if constexpr (F8) mfma8(acc[ai][bj][m][n], cat8(Bt[n][0], Bt[n][1]), cat8(At[m][0], At[m][1])); \
        else { _Pragma("unroll") for (int k = 0; k < 2; ++k) acc[ai][bj][m][n] = __builtin_amdgcn_mfma_f32_16x16x32_bf16(Bt[n][k], At[m][k], acc[ai][bj][m][n], 0, 0, 0); } } __builtin_amdgcn_s_setprio(0); } while (0)
#define PG8_WAIT_V(n) asm volatile("s_waitcnt vmcnt(" #n ")" ::: "memory")
#define PG8_WAIT_L(n) asm volatile("s_waitcnt lgkmcnt(" #n ")" ::: "memory")
#define PG8_BAR __builtin_amdgcn_s_barrier()
#define PG8_SCHED __builtin_amdgcn_sched_barrier(0)
    Unit cur, nxt; int ui = 0;
    if (!S.next(0, cur)) return;
    f32x4 acc[2][2][4][2];
#pragma unroll
    for (int a = 0; a < 2; ++a)
#pragma unroll
        for (int b = 0; b < 2; ++b)
#pragma unroll
            for (int m = 0; m < 4; ++m)
#pragma unroll
                for (int n = 0; n < 2; ++n) acc[a][b][m][n] = (f32x4){0.f, 0.f, 0.f, 0.f};
    bf16x8 At[4][2], B0[2][2], B1[2][2];
    const char* cA = (const char*)g.A + (size_t)cur.pm * tstep; const char* cB = (const char*)g.Bt + (size_t)cur.pn * tstep;
    S.a_ready(cur);
    PG8_STAGE(PG8_SB(0, 0), cB, voffB); PG8_STAGE(PG8_SA(0, 0), cA, voffA); PG8_STAGE(PG8_SB(0, 1), cB + hstep, voffB); PG8_STAGE(PG8_SA(0, 1), cA + hstep, voffA);
    if (wr == 1) PG8_BAR;
    PG8_WAIT_V(4); PG8_BAR;
    PG8_STAGE(PG8_SB(1, 0), cB + kstep, voffB); PG8_STAGE(PG8_SA(1, 0), cA + kstep, voffA); PG8_STAGE(PG8_SB(1, 1), cB + hstep + kstep, voffB);
    PG8_WAIT_V(6); PG8_BAR;
    for (;;) {
        const bool has_next = S.next(ui + 1, nxt);
        const char* nA = has_next ? (const char*)g.A + (size_t)nxt.pm * tstep : cA; const char* nB = has_next ? (const char*)g.Bt + (size_t)nxt.pn * tstep : cB;
        for (int t = 0; t < nt; t += 2) {
            const bool last = (t == nt - 2);
            const char* a1 = cA + (size_t)(t + 1) * kstep;
            const char* a2 = last ? nA : cA + (size_t)(t + 2) * kstep; const char* b2 = last ? nB : cB + (size_t)(t + 2) * kstep;
            const char* a3 = a2 + kstep; const char* b3 = b2 + kstep;
            if (last && has_next) S.a_ready(nxt);
            PG8_LDB(B0, 0, 0); PG8_SCHED; PG8_LDA(At, 0, 0); PG8_STAGE(PG8_SA(1, 1), a1 + hstep, voffA);
            PG8_WAIT_L(8); PG8_BAR; PG8_WAIT_L(0); PG8_MMA(0, 0, At, B0); PG8_BAR; PG8_SCHED;
            PG8_LDB(B1, 0, 1); PG8_STAGE(PG8_SB(0, 0), b2, voffB);
            PG8_BAR; PG8_WAIT_L(0); PG8_MMA(0, 1, At, B1); PG8_BAR;
            PG8_LDA(At, 0, 1); PG8_STAGE(PG8_SA(0, 0), a2, voffA);
            PG8_BAR; PG8_WAIT_L(0); PG8_MMA(1, 0, At, B0); PG8_BAR; PG8_SCHED;
            PG8_STAGE(PG8_SB(0, 1), b2 + hstep, voffB);
            PG8_WAIT_V(6); PG8_BAR; PG8_MMA(1, 1, At, B1); PG8_BAR;
            PG8_LDB(B0, 1, 0); PG8_SCHED; PG8_LDA(At, 1, 0); PG8_STAGE(PG8_SA(0, 1), a2 + hstep, voffA);
            PG8_WAIT_L(8); PG8_BAR; PG8_WAIT_L(0); PG8_MMA(0, 0, At, B0); PG8_BAR; PG8_SCHED;
            PG8_LDB(B1, 1, 1); PG8_STAGE(PG8_SB(1, 0), b3, voffB);
            PG8_BAR; PG8_WAIT_L(0); PG8_MMA(0, 1, At, B1); PG8_BAR;
            PG8_LDA(At, 1, 1); PG8_STAGE(PG8_SA(1, 0), a3, voffA);
            PG8_BAR; PG8_WAIT_L(0); PG8_MMA(1, 0, At, B0); PG8_BAR; PG8_SCHED;
            PG8_STAGE(PG8_SB(1, 1), b3 + hstep, voffB);
            PG8_WAIT_V(6); PG8_BAR; PG8_MMA(1, 1, At, B1); PG8_BAR;
        }
        if constexpr (F8) MFMA_DRAIN();
        E(acc, cur, wr, wc, fr, fq); S.done(cur);
        if (!has_next) break;
#pragma unroll
        for (int a = 0; a < 2; ++a)
#pragma unroll
            for (int b = 0; b < 2; ++b)
#pragma unroll
                for (int m = 0; m < 4; ++m)
#pragma unroll
                    for (int n = 0; n < 2; ++n) acc[a][b][m][n] = (f32x4){0.f, 0.f, 0.f, 0.f};
        cur = nxt; cA = nA; cB = nB; ++ui;
    }
    PG8_WAIT_V(0);
    if (wr == 0) PG8_BAR;
    PG8_BAR;
#undef PG8_SA
#undef PG8_SB
#undef PG8_STAGE
#undef PG8_LDA
#undef PG8_LDB
#undef PG8_MMA
#undef PG8_WAIT_V
#undef PG8_WAIT_L
#undef PG8_BAR
#undef PG8_SCHED
}
template <class Epi, class Sched, bool F8 = false>
__device__ __forceinline__ void gemm_phase_gather(LAS unsigned char* lds, const Gemm g, const Sched& S, const Epi& E, const int* rowtok) {
    int tid = threadIdx.x; asm volatile("" : "+v"(tid));
    const int wid = __builtin_amdgcn_readfirstlane(tid >> 6), lane = tid & 63, wr = wid >> 2, wc = wid & 3, fr = lane & 15, fq = lane >> 4;
    const int K = g.K, nt = K / BK;
    unsigned voffB[2]; int rA[2]; unsigned cA2[2];
#pragma unroll
    for (int i = 0; i < 2; ++i) { int R, C; stage_rc(tid * 16 + i * 8192, R, C); const int Rb = Epi::PERM ? ((R & ~31) + perm32(R & 31)) : R;
        rA[i] = R; cA2[i] = (unsigned)C * 2u; voffB[i] = (unsigned)(Rb * K + C) * 2u; }
    const unsigned rowb = (unsigned)K * 2u;
    unsigned ofsC[2][2], ofsN[2][2];
#define PG8_LOADOFS(dst, pm_) do { _Pragma("unroll") for (int h_ = 0; h_ < 2; ++h_) _Pragma("unroll") for (int i_ = 0; i_ < 2; ++i_) \
        dst[h_][i_] = (unsigned)rowtok[(pm_) * BM + h_ * HALF + rA[i_]] * rowb + cA2[i_]; asm volatile("" : "+v"(dst[0][0]), "+v"(dst[0][1]), "+v"(dst[1][0]), "+v"(dst[1][1])); } while (0)
#define PG8_STAGE_A(bufoff, kbyte, o0, o1) do { \
        __builtin_amdgcn_global_load_lds((const unsigned*)((const char*)g.A + (kbyte) + (o0)), (LAS unsigned*)(lds + (bufoff) + ldsw), 16, 0, 0); \
        __builtin_amdgcn_global_load_lds((const unsigned*)((const char*)g.A + (kbyte) + (o1)), (LAS unsigned*)(lds + (bufoff) + ldsw + 8192), 16, 0, 0); } while (0)
    const size_t kstep = (size_t)(BK * 2);
    const size_t hstep = (size_t)HALF * K * 2;
    const size_t tstep = 2 * hstep;
    const unsigned ldsw = (unsigned)wid * 1024u;
    const int aoff = lds_byte(wr * 64 + fr, fq * 8), boff = lds_byte(wc * 32 + fr, fq * 8);
#define PG8_SA(b, h) (((b) * 2 + (h)) * HTB)
#define PG8_SB(b, h) ((4 + (b) * 2 + (h)) * HTB)
#define PG8_STAGE(bufoff, gbase, voff) do { _Pragma("unroll") for (int _i = 0; _i < 2; ++_i) \
        __builtin_amdgcn_global_load_lds((const unsigned*)((const char*)(gbase) + (voff)[_i]), (LAS unsigned*)(lds + (bufoff) + ldsw + _i * 8192), 16, 0, 0); } while (0)
#define PG8_LDA(dst, b, h) do { _Pragma("unroll") for (int m = 0; m < 4; ++m) _Pragma("unroll") for (int k = 0; k < 2; ++k) dst[m][k] = *(const LAS bf16x8*)(lds + PG8_SA(b, h) + aoff + m * 2048 + k * 1024); } while (0)
#define PG8_LDB(dst, b, h) do { _Pragma("unroll") for (int n = 0; n < 2; ++n) _Pragma("unroll") for (int k = 0; k < 2; ++k) dst[n][k] = *(const LAS bf16x8*)(lds + PG8_SB(b, h) + boff + n * 2048 + k * 1024); } while (0)
#define PG8_MMA(ai, bj, At, Bt) do { __builtin_amdgcn_s_setprio(1); _Pragma("unroll") for (int m = 0; m < 4; ++m) _Pragma("unroll") for (int n = 0; n < 2; ++n) { \
        if constexpr (F8) mfma8(acc[ai][bj][m][n], cat8(Bt[n][0], Bt[n][1]), cat8(At[m][0], At[m][1])); \
        else { _Pragma("unroll") for (int k = 0; k < 2; ++k) acc[ai][bj][m][n] = __builtin_amdgcn_mfma_f32_16x16x32_bf16(Bt[n][k], At[m][k], acc[ai][bj][m][n], 0, 0, 0); } } __builtin_amdgcn_s_setprio(0); } while (0)
#define PG8_WAIT_V(n) asm volatile("s_waitcnt vmcnt(" #n ")" ::: "memory")
#define PG8_WAIT_L(n) asm volatile("s_waitcnt lgkmcnt(" #n ")" ::: "memory")
#define PG8_BAR __builtin_amdgcn_s_barrier()
#define PG8_SCHED __builtin_amdgcn_sched_barrier(0)
    Unit cur, nxt; int ui = 0;
    if (!S.next(0, cur)) return;
    f32x4 acc[2][2][4][2];
#pragma unroll
    for (int a = 0; a < 2; ++a)
#pragma unroll
        for (int b = 0; b < 2; ++b)
#pragma unroll
            for (int m = 0; m < 4; ++m)
#pragma unroll
                for (int n = 0; n < 2; ++n) acc[a][b][m][n] = (f32x4){0.f, 0.f, 0.f, 0.f};
    bf16x8 At[4][2], B0[2][2], B1[2][2];
    const char* cB = (const char*)g.Bt + (size_t)cur.pn * tstep;
    PG8_LOADOFS(ofsC, cur.pm);
    PG8_STAGE(PG8_SB(0, 0), cB, voffB); PG8_STAGE_A(PG8_SA(0, 0), 0, ofsC[0][0], ofsC[0][1]); PG8_STAGE(PG8_SB(0, 1), cB + hstep, voffB); PG8_STAGE_A(PG8_SA(0, 1), 0, ofsC[1][0], ofsC[1][1]);
    if (wr == 1) PG8_BAR;
    PG8_WAIT_V(4); PG8_BAR;
    PG8_STAGE(PG8_SB(1, 0), cB + kstep, voffB); PG8_STAGE_A(PG8_SA(1, 0), kstep, ofsC[0][0], ofsC[0][1]); PG8_STAGE(PG8_SB(1, 1), cB + hstep + kstep, voffB);
    PG8_WAIT_V(6); PG8_BAR;
    for (;;) {
        const bool has_next = S.next(ui + 1, nxt);
        const char* nB = has_next ? (const char*)g.Bt + (size_t)nxt.pn * tstep : cB;
        if (has_next) PG8_LOADOFS(ofsN, nxt.pm); else { ofsN[0][0] = ofsC[0][0]; ofsN[0][1] = ofsC[0][1]; ofsN[1][0] = ofsC[1][0]; ofsN[1][1] = ofsC[1][1]; }
        for (int t = 0; t < nt; t += 2) {
            const bool last = (t == nt - 2);
            const size_t k1 = (size_t)(t + 1) * kstep, k2 = last ? 0 : (size_t)(t + 2) * kstep, k3 = k2 + kstep;
            const char* b2 = last ? nB : cB + (size_t)(t + 2) * kstep; const char* b3 = b2 + kstep;
            const unsigned o00 = last ? ofsN[0][0] : ofsC[0][0], o01 = last ? ofsN[0][1] : ofsC[0][1], o10 = last ? ofsN[1][0] : ofsC[1][0], o11 = last ? ofsN[1][1] : ofsC[1][1];
            PG8_LDB(B0, 0, 0); PG8_SCHED; PG8_LDA(At, 0, 0); PG8_STAGE_A(PG8_SA(1, 1), k1, ofsC[1][0], ofsC[1][1]);
            PG8_WAIT_L(8); PG8_BAR; PG8_WAIT_L(0); PG8_MMA(0, 0, At, B0); PG8_BAR; PG8_SCHED;
            PG8_LDB(B1, 0, 1); PG8_STAGE(PG8_SB(0, 0), b2, voffB);
            PG8_BAR; PG8_WAIT_L(0); PG8_MMA(0, 1, At, B1); PG8_BAR;
            PG8_LDA(At, 0, 1); PG8_STAGE_A(PG8_SA(0, 0), k2, o00, o01);
            PG8_BAR; PG8_WAIT_L(0); PG8_MMA(1, 0, At, B0); PG8_BAR; PG8_SCHED;
            PG8_STAGE(PG8_SB(0, 1), b2 + hstep, voffB);
            PG8_WAIT_V(6); PG8_BAR; PG8_MMA(1, 1, At, B1); PG8_BAR;
            PG8_LDB(B0, 1, 0); PG8_SCHED; PG8_LDA(At, 1, 0); PG8_STAGE_A(PG8_SA(0, 1), k2, o10, o11);
            PG8_WAIT_L(8); PG8_BAR; PG8_WAIT_L(0); PG8_MMA(0, 0, At, B0); PG8_BAR; PG8_SCHED;
            PG8_LDB(B1, 1, 1); PG8_STAGE(PG8_SB(1, 0), b3, voffB);
            PG8_BAR; PG8_WAIT_L(0); PG8_MMA(0, 1, At, B1); PG8_BAR;
            PG8_LDA(At, 1, 1); PG8_STAGE_A(PG8_SA(1, 0), k3, o00, o01);
            PG8_BAR; PG8_WAIT_L(0); PG8_MMA(1, 0, At, B0); PG8_BAR; PG8_SCHED;
            PG8_STAGE(PG8_SB(1, 1), b3 + hstep, voffB);
            PG8_WAIT_V(6); PG8_BAR; PG8_MMA(1, 1, At, B1); PG8_BAR;
        }
        if constexpr (F8) MFMA_DRAIN();
        E(acc, cur, wr, wc, fr, fq); S.done(cur);
        if (!has_next) break;
#pragma unroll
        for (int a = 0; a < 2; ++a)
#pragma unroll
            for (int b = 0; b < 2; ++b)
#pragma unroll
                for (int m = 0; m < 4; ++m)
#pragma unroll
                    for (int n = 0; n < 2; ++n) acc[a][b][m][n] = (f32x4){0.f, 0.f, 0.f, 0.f};
        cur = nxt; cB = nB; ++ui; ofsC[0][0] = ofsN[0][0]; ofsC[0][1] = ofsN[0][1]; ofsC[1][0] = ofsN[1][0]; ofsC[1][1] = ofsN[1][1];
    }
    PG8_WAIT_V(0);
    if (wr == 0) PG8_BAR;
    PG8_BAR;
#undef PG8_SA
#undef PG8_LOADOFS
#undef PG8_STAGE_A
#undef PG8_SB
#undef PG8_STAGE
#undef PG8_LDA
#undef PG8_LDB
#undef PG8_MMA
#undef PG8_WAIT_V
#undef PG8_WAIT_L
#undef PG8_BAR
#undef PG8_SCHED
}
}

enum InIdx { I_X = 0, I_MEM, I_GMIX, I_WIN, I_WOUT, I_POOLW, I_POOLS, I_GMEM, I_GMEMKV, I_WMQ, I_WMK, I_WMV, I_WMO, I_GFFN, I_WGROUP, I_BGROUP, I_WROUTER, I_BROUTER, I_W1, I_W3, I_W2, I_GFINAL, N_IN };
struct Args { const float* in[N_IN]; float* out; unsigned char* ws; int ph_lo, ph_hi, li, pad; };

typedef const __attribute__((address_space(4))) Args* CArgsP;
__device__ __forceinline__ CArgsP kargs() { CArgsP p = (CArgsP)__builtin_amdgcn_kernarg_segment_ptr(); asm volatile("" : "+s"(p)); return p; }

struct Frame {
    LAS unsigned char* lds;
    int tid, lane, wave, gw, NGW, G;
};
__device__ __forceinline__ Frame make_frame(LAS unsigned char* lds) {
    Frame F; int tz = threadIdx.x; asm volatile("" : "+v"(tz));
    F.lds = lds; F.tid = tz; F.lane = tz & 63; F.wave = __builtin_amdgcn_readfirstlane(tz >> 6);
    F.G = gridDim.x; F.gw = blockIdx.x * 8 + F.wave; F.NGW = F.G * 8;
    return F;
}

__device__ __forceinline__ void conv_item(const float* W, int K, int N, const float* gain, bf16_t* WT, int rowbase, int blkshift, int blkstride, LAS float* scr_, int item, int lane) {
    LAS unsigned char* scr = (LAS unsigned char*)scr_;
    const int nblk = N / 64, kb = item / nblk, nb = item % nblk, k0 = 64 * kb, n0 = 64 * nb;
    const int nq = lane & 15, kr = lane >> 4;
    f32x4 v[16];
#pragma unroll
    for (int i = 0; i < 16; ++i) v[i] = *(const f32x4*)(W + (size_t)(k0 + 16 * (i >> 2) + 4 * kr + (i & 3)) * N + n0 + 4 * nq);
    if (gain) {
#pragma unroll
        for (int kbk = 0; kbk < 4; ++kbk) { const f32x4 g4 = *(const f32x4*)(gain + k0 + 16 * kbk + 4 * kr);
#pragma unroll
            for (int c = 0; c < 4; ++c) v[4 * kbk + c] = v[4 * kbk + c] * g4[c]; }
    }
#pragma unroll
    for (int kbk = 0; kbk < 4; ++kbk)
#pragma unroll
        for (int j = 0; j < 4; ++j) { u32x2 w; w.x = pk2(v[4 * kbk][j], v[4 * kbk + 1][j]); w.y = pk2(v[4 * kbk + 2][j], v[4 * kbk + 3][j]);
            *(LAS u32x2*)(scr + (4 * nq + j) * 144 + kbk * 32 + 8 * kr) = w; }
    LDS_WAIT();
    const int c = lane & 7;
    const int drow0 = rowbase + (n0 >> blkshift) * blkstride + (n0 & ((1 << blkshift) - 1));
#pragma unroll
    for (int i = 0; i < 8; ++i) { const int n = (lane >> 3) + 8 * i; const u32x4 o = *(const LAS u32x4*)(scr + n * 144 + 16 * c);
        const int drow = drow0 + n;
        *(u32x4*)(WT + (size_t)drow * K + k0 + 8 * c) = o; }
    LDS_WAIT();
}

__device__ __forceinline__ void conv_item8(const float* W, int K, int N, const float* gain, float scale, unsigned char* WT, int rowbase, int blkshift, int blkstride, LAS float* scr_, int item, int lane) {
    LAS unsigned char* scr = (LAS unsigned char*)scr_;
    const int nblk = N / 64, kb = item / nblk, nb = item % nblk, k0 = 64 * kb, n0 = 64 * nb;
    const int nq = lane & 15, kr = lane >> 4;
    f32x4 v[16];
#pragma unroll
    for (int i = 0; i < 16; ++i) v[i] = *(const f32x4*)(W + (size_t)(k0 + 16 * (i >> 2) + 4 * kr + (i & 3)) * N + n0 + 4 * nq);
#pragma unroll
    for (int kbk = 0; kbk < 4; ++kbk) { const f32x4 g4 = gain ? *(const f32x4*)(gain + k0 + 16 * kbk + 4 * kr) * scale : (f32x4){scale, scale, scale, scale};
#pragma unroll
        for (int c = 0; c < 4; ++c) v[4 * kbk + c] = v[4 * kbk + c] * g4[c]; }
#pragma unroll
    for (int kbk = 0; kbk < 4; ++kbk)
#pragma unroll
        for (int j = 0; j < 4; ++j) *(LAS unsigned*)(scr + (4 * nq + j) * 80 + kbk * 16 + 4 * kr) = pk4f8((f32x4){v[4 * kbk][j], v[4 * kbk + 1][j], v[4 * kbk + 2][j], v[4 * kbk + 3][j]});
    LDS_WAIT();
    const int c = lane & 3;
    const int drow0 = rowbase + (n0 >> blkshift) * blkstride + (n0 & ((1 << blkshift) - 1));
#pragma unroll
    for (int i = 0; i < 4; ++i) { const int n = (lane >> 2) + 16 * i; const u32x4 o = *(const LAS u32x4*)(scr + n * 80 + 16 * c);
        *(u32x4*)(WT + (size_t)(drow0 + n) * K + k0 + 16 * c) = o; }
    LDS_WAIT();
}

__device__ __forceinline__ bool inproj_tile_bf16(int tile) { return tile == 12 || tile == 13 || tile >= 18; }
__device__ __forceinline__ void phase_prologue(LAS unsigned char* lds) {
    CArgsP ap = kargs(); Frame F = make_frame(lds);
    unsigned char* ws = ap->ws;
    LAS float* scr = (LAS float*)(F.lds + F.wave * 16384);
    bf16_t* win_t = (bf16_t*)(ws + WS_WIN); bf16_t* wout_t = (bf16_t*)(ws + WS_WOUT); bf16_t* wc_t = (bf16_t*)(ws + WS_WC); bf16_t* wmo_t = (bf16_t*)(ws + WS_WMO);
    constexpr int IT_IN = 32 * 80, IT_OUT = 24 * 32, IT_M = 32 * 8, IT_MO = 8 * 32;
    constexpr int IT_SMALL = IT_IN + IT_OUT + 3 * IT_M + IT_MO;
    for (int it = F.gw; it < 2 * IT_SMALL; it += F.NGW) {
        int r = it;
        const int l = r / IT_SMALL; r -= l * IT_SMALL;
        if (r < IT_IN) { const int tile = (r % 80) >> 2;
            if (inproj_tile_bf16(tile)) conv_item(ap->in[I_WIN] + (size_t)l * D * INC, D, INC, ap->in[I_GMIX] + l * D, win_t + (size_t)l * INC * D, 0, 30, 0, scr, r, F.lane);
            else conv_item8(ap->in[I_WIN] + (size_t)l * D * INC, D, INC, ap->in[I_GMIX] + l * D, W8_SCALE, ws + WS_WIN8 + (size_t)l * INC * D, 0, 30, 0, scr, r, F.lane);
            continue; } r -= IT_IN;
        if (r < IT_OUT) { conv_item(ap->in[I_WOUT] + (size_t)l * D * D, D, D, nullptr, wout_t + (size_t)l * D * D, 0, 30, 0, scr, r, F.lane); continue; } r -= IT_OUT;
        if (r < IT_M) { conv_item(ap->in[I_WMQ] + (size_t)l * D * 512, D, 512, ap->in[I_GMEM] + l * D, wc_t, l ? 2560 : 0, 30, 0, scr, r, F.lane); continue; } r -= IT_M;
        if (r < IT_M) { conv_item(ap->in[I_WMK] + (size_t)l * D * 512, D, 512, ap->in[I_GMEMKV] + l * D, wc_t, 512 + 1024 * l, 30, 0, scr, r, F.lane); continue; } r -= IT_M;
        if (r < IT_M) { conv_item(ap->in[I_WMV] + (size_t)l * D * 512, D, 512, ap->in[I_GMEMKV] + l * D, wc_t, 1024 + 1024 * l, 30, 0, scr, r, F.lane); continue; } r -= IT_M;
        conv_item(ap->in[I_WMO] + (size_t)l * 512 * D, 512, D, nullptr, wmo_t + (size_t)l * D * 512, 0, 30, 0, scr, r, F.lane);
    }
    __syncthreads();
    for (int it = blockIdx.x; it < 2 * 4 * 32; it += F.G) {
        const int l = it >> 7, g = (it >> 5) & 3, n0 = (it & 31) * 64;
        LAS float* Ap = (LAS float*)F.lds;
        LAS float* Bp = (LAS float*)(F.lds + 65536);
        const float* pw = ap->in[I_POOLW] + (size_t)(l * 4 + g) * 128 * 128; const float* psc = ap->in[I_POOLS] + l * 512 + g * 128;
        const float* wo = ap->in[I_WOUT] + (size_t)l * D * D + (size_t)(1536 + g * 128) * D + n0;
        for (int i = F.tid; i < 128 * 128; i += 512) Ap[i] = pw[i] * psc[i & 127];
        for (int i = F.tid; i < 128 * 64; i += 512) Bp[i] = wo[(size_t)(i >> 6) * D + (i & 63)];
        __syncthreads();
        const int nl = F.tid & 63, cg = F.tid >> 6;
        float acc[16];
#pragma unroll
        for (int cc = 0; cc < 16; ++cc) acc[cc] = 0.f;
        for (int d4 = 0; d4 < 32; ++d4) {
            const float w0 = Bp[(4 * d4 + 0) * 64 + nl], w1 = Bp[(4 * d4 + 1) * 64 + nl], w2 = Bp[(4 * d4 + 2) * 64 + nl], w3 = Bp[(4 * d4 + 3) * 64 + nl];
#pragma unroll
            for (int cc = 0; cc < 16; ++cc) { const f32x4 a4 = *(const LAS f32x4*)(Ap + (cg * 16 + cc) * 128 + 4 * d4); acc[cc] += a4[0] * w0 + a4[1] * w1 + a4[2] * w2 + a4[3] * w3; }
        }
        bf16_t* dst = wout_t + (size_t)l * D * D + (size_t)(n0 + nl) * D + 1536 + g * 128 + cg * 16;
        u32x4 o0, o1; o0.x = pk2(acc[0], acc[1]); o0.y = pk2(acc[2], acc[3]); o0.z = pk2(acc[4], acc[5]); o0.w = pk2(acc[6], acc[7]);
        o1.x = pk2(acc[8], acc[9]); o1.y = pk2(acc[10], acc[11]); o1.z = pk2(acc[12], acc[13]); o1.w = pk2(acc[14], acc[15]);
        *(u32x4*)dst = o0; *(u32x4*)(dst + 8) = o1;
        __syncthreads();
    }
    { float* wrt = (float*)(ws + WS_SMALL + SM_WRT);
      for (int i = blockIdx.x * 512 + F.tid; i < 2 * 48 * D; i += F.G * 512) { const int l = i / (48 * D), c = (i / D) % 48, k = i % D;
          float v = 0.f;
          if (c < 4) v = ap->in[I_WGROUP][(size_t)(l * D + k) * 4 + c]; else if (c < 36) v = ap->in[I_WROUTER][((size_t)(l * 4 + ((c - 4) >> 3)) * D + k) * 8 + ((c - 4) & 7)];
          wrt[i] = v * ap->in[I_GFFN][l * D + k]; } }
    bf16_t* xb = (bf16_t*)(ws + WS_XB); float* rs_all = (float*)(ws + WS_SMALL + SM_RSALL);
    const float* xin = ap->in[I_X]; const float* memin = ap->in[I_MEM];
    for (int row = F.gw; row < NTOK_ALL; row += F.NGW) {
        const float* src = row < T ? xin + (size_t)row * D : memin + (size_t)(row - T) * D;
        f32x4 v[8]; float ss = 0.f;
#pragma unroll
        for (int i = 0; i < 8; ++i) { v[i] = *(const f32x4*)(src + 4 * F.lane + 256 * i); ss += (v[i][0] * v[i][0] + v[i][1] * v[i][1]) + (v[i][2] * v[i][2] + v[i][3] * v[i][3]); }
        ss = wave_sum(ss);
        if (F.lane == 0) rs_all[row] = 1.0f / sqrtf(ss * (1.0f / D) + RMS_EPS);
#pragma unroll
        for (int i = 0; i < 8; ++i) { u32x2 w; w.x = pk2(v[i][0], v[i][1]); w.y = pk2(v[i][2], v[i][3]); *(u32x2*)(xb + (size_t)row * D + 4 * F.lane + 256 * i) = w; }
        if (row < T) {
#pragma unroll
            for (int i = 0; i < 8; ++i) *(unsigned*)(ws + WS_XI8 + (size_t)row * D + 4 * F.lane + 256 * i) = pk4f8(v[i] * X8_SCALE);
        }
    }
}
constexpr int CONV_MOE_ITEMS = 32 * 3 * 256;
__device__ __forceinline__ int memq_busy(int l) { return l == 0 ? 144 : 128; }
__device__ __forceinline__ int conv_moe_split(int G, int l) { return G >= memq_busy(l) + 64 ? (l == 0 ? 22 : 20) * 3 * 256 : CONV_MOE_ITEMS; }
__device__ __forceinline__ void conv_moe(CArgsP ap, Frame& F, int l, int it_lo, int it_hi, int gw, int ngw) {
    unsigned char* ws = ap->ws;
    LAS float* scr = (LAS float*)(F.lds + 16384 + F.wave * 12288);
    bf16_t* w13_t = (bf16_t*)(ws + WS_W13); bf16_t* w2_t = (bf16_t*)(ws + WS_W2);
    constexpr int IT_E = 256;
    const float* gf = ap->in[I_GFFN] + l * D;
    for (int it = it_lo + gw; it < it_hi; it += ngw) {
        int r = it;
        const int e = r / (3 * IT_E); r -= e * 3 * IT_E;
        const int which = r / IT_E; r -= which * IT_E;
        const size_t eoff = (size_t)(l * 32 + e) * D * 512;
        if (which == 0) conv_item8(ap->in[I_W1] + eoff, D, 512, gf, W8_SCALE, (unsigned char*)w13_t, e * 1024, 7, 256, scr, r, F.lane);
        else if (which == 1) conv_item8(ap->in[I_W3] + eoff, D, 512, gf, W8_SCALE, (unsigned char*)w13_t, e * 1024 + 128, 7, 256, scr, r, F.lane);
        else conv_item8(ap->in[I_W2] + eoff, 512, D, nullptr, W28_SCALE, (unsigned char*)w2_t, e * D, 30, 0, scr, r, F.lane);
    }
}

__device__ __forceinline__ float alibi_slope(int i) { return exp2f(-8.0f * (float)(i + 1) / 12.0f); }

typedef short s16x4 __attribute__((ext_vector_type(4)));
constexpr float LOG2E = 1.4426950408889634f;
__device__ __forceinline__ int koff(int key, int ch) { return 256 * key + 16 * (ch ^ ((((key >> 3) & 3) << 2) | (key & 3))); }
__device__ __forceinline__ int voff(int key, int ch) { return 256 * key + 16 * (ch ^ (((key & 3) << 2) | ((key >> 2) & 3))); }
__device__ __forceinline__ s16x4 vtr(LAS const unsigned char* p) { return __builtin_bit_cast(s16x4, __builtin_amdgcn_ds_read_tr16_b64_v4i16((LAS s16x4*)p)); }
__device__ __forceinline__ bf16x8 pack8(float a0, float a1, float a2, float a3, float b0, float b1, float b2, float b3) {
    u32x4 p;
    asm volatile("v_cvt_pk_bf16_f32 %0, %4, %5\n\tv_cvt_pk_bf16_f32 %1, %6, %7\n\tv_cvt_pk_bf16_f32 %2, %8, %9\n\tv_cvt_pk_bf16_f32 %3, %10, %11\n\ts_nop 1"
                 : "=&v"(p[0]), "=&v"(p[1]), "=&v"(p[2]), "=&v"(p[3]) : "v"(a0), "v"(a1), "v"(a2), "v"(a3), "v"(b0), "v"(b1), "v"(b2), "v"(b3));
    return __builtin_bit_cast(bf16x8, p);
}
__device__ __forceinline__ void stage_kv(LAS unsigned char* lds, const bf16_t* Kg, const bf16_t* Vg, int stride, int row0, int step, int minrow, int tid_) {
    int tid = tid_; asm volatile("" : "+v"(tid));
    const int lane = tid & 63, w = __builtin_amdgcn_readfirstlane(tid >> 6), q = lane >> 4, c = lane & 15;
    const int chK = c ^ ((((w >> 1) & 3) << 2) | q), chV = c ^ ((q << 2) | (w & 3));
#pragma unroll
    for (int i = 0; i < 8; ++i) { const int key = 32 * i + 4 * w + q; int row = row0 + key * step; row = row < minrow ? minrow : row;
        const size_t o = (size_t)row * stride;
        __builtin_amdgcn_global_load_lds((const unsigned*)(Kg + o + 8 * chK), (LAS unsigned*)(lds + 256 * (32 * i + 4 * w)), 16, 0, 0);
        __builtin_amdgcn_global_load_lds((const unsigned*)(Vg + o + 8 * chV), (LAS unsigned*)(lds + 65536 + 256 * (32 * i + 4 * w)), 16, 0, 0); }
    asm volatile("s_waitcnt vmcnt(0)" ::: "memory");
}
template <int NP, bool OUT8>
__device__ __forceinline__ void attn_tile_wave(LAS const unsigned char* lds, int kp0, const bf16_t* qptr, float qscale, float Q0, float Dmax, float kmin, float slope2, bool mask_on,
                                               bf16_t* optr, float* mlptr, bool qvalid, int lane) {
    const int n = lane & 15, g = lane >> 4;
    LAS const unsigned char* Kimg = lds; LAS const unsigned char* Vimg = lds + 65536;
    bf16x8 qf[4];
#pragma unroll
    for (int ks = 0; ks < 4; ++ks) qf[ks] = *(const bf16x8*)(qptr + 32 * ks + 8 * g);
    const float kb = (float)(32 * kp0 + 8 * g);
    const float based = Q0 - kb;
    const float lowC = fmaxf(based - Dmax, kmin - kb);
    const float rq = 1.0f / qscale, u = slope2 * rq, b0q = -slope2 * based * rq;
    f32x4 acc[NP][2];
#pragma unroll
    for (int kp = 0; kp < NP; ++kp)
#pragma unroll
        for (int t = 0; t < 2; ++t)
#pragma unroll
            for (int i = 0; i < 4; ++i) acc[kp][t][i] = __builtin_fmaf(u, (float)(32 * kp + 4 * t + i), b0q);
    if (mask_on) {
#pragma unroll
        for (int kp = 0; kp < NP; ++kp)
#pragma unroll
            for (int t = 0; t < 2; ++t)
#pragma unroll
                for (int i = 0; i < 4; ++i) { const float C = (float)(32 * kp + 4 * t + i); acc[kp][t][i] = (C <= based && C >= lowC) ? acc[kp][t][i] : -INFINITY; }
    }
    const int krow = 32 * kp0 + 8 * (n >> 2) + (n & 3);
    {
        bf16x8 kbuf[2][4];
#define LDK(buf, tt) do { const int key_ = krow + 32 * ((tt) >> 1) + 4 * ((tt) & 1); _Pragma("unroll") for (int ks = 0; ks < 4; ++ks) kbuf[buf][ks] = *(LAS const bf16x8*)(Kimg + koff(key_, 4 * ks + g)); } while (0)
        LDK(0, 0);
        __builtin_amdgcn_sched_barrier(0);
#pragma unroll
        for (int tt = 0; tt < 2 * NP; ++tt) {
            if (tt + 1 < 2 * NP) LDK((tt + 1) & 1, tt + 1);
            __builtin_amdgcn_sched_barrier(0);
#pragma unroll
            for (int ks = 0; ks < 4; ++ks) acc[tt >> 1][tt & 1] = __builtin_amdgcn_mfma_f32_16x16x32_bf16(kbuf[tt & 1][ks], qf[ks], acc[tt >> 1][tt & 1], 0, 0, 0);
            __builtin_amdgcn_sched_barrier(0);
        }
#undef LDK
    }
    float m = -INFINITY;
#pragma unroll
    for (int kp = 0; kp < NP; ++kp)
#pragma unroll
        for (int t = 0; t < 2; ++t) m = fmaxf(fmaxf(m, fmaxf(acc[kp][t][0], acc[kp][t][1])), fmaxf(acc[kp][t][2], acc[kp][t][3]));
    m = fmaxf(m, __shfl_xor(m, 16)); m = fmaxf(m, __shfl_xor(m, 32));
    const float mraw = (m == -INFINITY) ? 0.f : m;
    const float ms = mraw * qscale, nms = -ms;
    float lsum = 0.f;
    bf16x8 pf[NP];
#pragma unroll
    for (int kp = 0; kp < NP; ++kp) { float p[8];
#pragma unroll
        for (int t = 0; t < 2; ++t)
#pragma unroll
            for (int i = 0; i < 4; ++i) { p[4 * t + i] = __builtin_amdgcn_exp2f(__builtin_fmaf(acc[kp][t][i], qscale, nms)); lsum += p[4 * t + i]; }
        pf[kp] = pack8(p[0], p[1], p[2], p[3], p[4], p[5], p[6], p[7]); }
    lsum += __shfl_xor(lsum, 16); lsum += __shfl_xor(lsum, 32);
    f32x4 o[8];
#pragma unroll
    for (int dt = 0; dt < 8; ++dt) o[dt] = (f32x4){0.f, 0.f, 0.f, 0.f};
    const int q4 = n >> 2, p4 = n & 3;
    {
        s16x4 vlo[2][4], vhi[2][4];
#define LDV(buf, ss) do { const int r0_ = 32 * (kp0 + ((ss) >> 1)) + 8 * g + q4; _Pragma("unroll") for (int d4 = 0; d4 < 4; ++d4) { const int dt_ = 4 * ((ss) & 1) + d4; \
            vlo[buf][d4] = vtr(Vimg + voff(r0_, 2 * dt_ + (p4 >> 1)) + 8 * (p4 & 1)); vhi[buf][d4] = vtr(Vimg + voff(r0_ + 4, 2 * dt_ + (p4 >> 1)) + 8 * (p4 & 1)); } } while (0)
        LDV(0, 0);
        __builtin_amdgcn_sched_barrier(0);
#pragma unroll
        for (int ss = 0; ss < 2 * NP; ++ss) {
            if (ss + 1 < 2 * NP) LDV((ss + 1) & 1, ss + 1);
            __builtin_amdgcn_sched_barrier(0);
#pragma unroll
            for (int d4 = 0; d4 < 4; ++d4) { const bf16x8 vf = __builtin_shufflevector(vlo[ss & 1][d4], vhi[ss & 1][d4], 0, 1, 2, 3, 4, 5, 6, 7);
                o[4 * (ss & 1) + d4] = __builtin_amdgcn_mfma_f32_16x16x32_bf16(vf, pf[ss >> 1], o[4 * (ss & 1) + d4], 0, 0, 0); }
            __builtin_amdgcn_sched_barrier(0);
        }
#undef LDV
    }
    if (qvalid) {
        const float inv = 1.0f / lsum;
        if (OUT8) {
            const float i16 = inv * 16.0f; int w[8];
#pragma unroll
            for (int dt = 0; dt < 8; ++dt) { int v = 0; v = __builtin_amdgcn_cvt_pk_fp8_f32(o[dt][0] * i16, o[dt][1] * i16, v, false); v = __builtin_amdgcn_cvt_pk_fp8_f32(o[dt][2] * i16, o[dt][3] * i16, v, true); w[dt] = v; }
            u32x4 w0, w1; w0.x = (unsigned)w[0]; w0.y = (unsigned)w[1]; w0.z = (unsigned)w[2]; w0.w = (unsigned)w[3]; w1.x = (unsigned)w[4]; w1.y = (unsigned)w[5]; w1.z = (unsigned)w[6]; w1.w = (unsigned)w[7];
            *(u32x4*)((unsigned char*)optr + 32 * g) = w0; *(u32x4*)((unsigned char*)optr + 32 * g + 16) = w1;
        } else {
#pragma unroll
            for (int dt = 0; dt < 8; ++dt) { u32x2 w; w.x = pk2(o[dt][0] * inv, o[dt][1] * inv); w.y = pk2(o[dt][2] * inv, o[dt][3] * inv); *(u32x2*)(optr + 16 * dt + 4 * g) = w; }
        }
        if (mlptr != nullptr && g == 0) { f32x2 mlv; mlv.x = ms; mlv.y = lsum; *(f32x2*)mlptr = mlv; }
    }
}

__device__ __forceinline__ void phase_inproj(LAS unsigned char* lds, int l) {
    CArgsP ap = kargs(); unsigned char* ws = ap->ws; const int G = gridDim.x;
    {
        pg8::Gemm g{(const bf16_t*)(ws + WS_XI8), (const bf16_t*)(ws + WS_WIN8 + (size_t)l * INC * D), T, INC, D / 2}; pg8::SubsetOrder S; S.so.init(T, 16 * 256, G, (int)blockIdx.x); S.l0 = 12; S.b0 = 0; S.l1 = 4; S.b1 = 14; S.b2 = 0;
        pg8::EpiScaleBf16 E{(bf16_t*)(ws + WS_P), INC, (const float*)(ws + WS_SMALL + SM_RSALL), (float*)(ws + WS_SMALL + SM_KMH), 1.0f / (X8_SCALE * W8_SCALE)};
        pg8::gemm_phase<pg8::EpiScaleBf16, pg8::SubsetOrder, true>(lds, g, S, E);
    }
    __syncthreads();
    {
        pg8::Gemm g{(const bf16_t*)(ws + WS_XB), (const bf16_t*)(ws + WS_WIN) + (size_t)l * INC * D, T, INC, D}; pg8::SubsetOrder S; S.so.init(T, 4 * 256, G, (int)blockIdx.x); S.l0 = 2; S.b0 = 12; S.l1 = 2; S.b1 = 18; S.b2 = 0;
        pg8::EpiScaleBf16 E{(bf16_t*)(ws + WS_P), INC, (const float*)(ws + WS_SMALL + SM_RSALL), (float*)(ws + WS_SMALL + SM_KMH), 1.0f};
        pg8::gemm_phase<pg8::EpiScaleBf16, pg8::SubsetOrder, false>(lds, g, S, E);
    }
}
struct Top3 { float v0, v1, v2; int i0, i1, i2; };
__device__ __forceinline__ bool t3_better(float a, int ai, float b, int bi) { return a > b || (a == b && ai < bi); }
__device__ __forceinline__ void t3_insert(Top3& t, float v, int idx) {
    const bool b0 = t3_better(v, idx, t.v0, t.i0), b1 = t3_better(v, idx, t.v1, t.i1), b2 = t3_better(v, idx, t.v2, t.i2);
    t.v2 = b1 ? t.v1 : (b2 ? v : t.v2); t.i2 = b1 ? t.i1 : (b2 ? idx : t.i2);
    t.v1 = b0 ? t.v0 : (b1 ? v : t.v1); t.i1 = b0 ? t.i0 : (b1 ? idx : t.i1);
    t.v0 = b0 ? v : t.v0; t.i0 = b0 ? idx : t.i0;
}
__device__ __forceinline__ void phase_gate(LAS unsigned char* lds, int l) {
    CArgsP ap = kargs(); Frame F = make_frame(lds); unsigned char* ws = ap->ws;
    const bf16_t* Pb = (const bf16_t*)(ws + WS_P); const float* kpart = (const float*)(ws + WS_SMALL + SM_KMH); bf16_t* mix = (bf16_t*)(ws + WS_MIX);
    int* sel = (int*)(ws + WS_SMALL + SM_SEL); int* list = (int*)(ws + WS_SMALL + SM_LIST); unsigned* lcnt = (unsigned*)(ws + WS_CTL) + CW_LCNT + 512 * CPAD * l;
    const int n16 = F.lane & 15, g = F.lane >> 4;
    for (int item = F.gw; item < 16 * 128; item += F.NGW) {
        const int bh = item >> 7, chunk = item & 127, b = bh >> 3, h = bh & 7, t0 = chunk * 64, own = t0 >> 8;
        bf16x8 kh[2][4], kl[2][4];
#pragma unroll
        for (int t2 = 0; t2 < 2; ++t2)
#pragma unroll
            for (int ks = 0; ks < 4; ++ks) {
                const float* p0 = kpart + (size_t)(b * 32 + 16 * t2 + n16) * 1024 + h * 128 + 32 * ks + 8 * g; const float* p1 = p0 + (size_t)64 * 1024;
                const f32x4 a0 = (*(const f32x4*)p0 + *(const f32x4*)p1) * (1.0f / 256.0f), a1 = (*(const f32x4*)(p0 + 4) + *(const f32x4*)(p1 + 4)) * (1.0f / 256.0f);
                const unsigned h0 = f2bf(a0[0]), h1 = f2bf(a0[1]), h2 = f2bf(a0[2]), h3 = f2bf(a0[3]), h4 = f2bf(a1[0]), h5 = f2bf(a1[1]), h6 = f2bf(a1[2]), h7 = f2bf(a1[3]);
                u32x4 hv; hv.x = h0 | (h1 << 16); hv.y = h2 | (h3 << 16); hv.z = h4 | (h5 << 16); hv.w = h6 | (h7 << 16);
                u32x4 lv; lv.x = pk2(a0[0] - __builtin_bit_cast(float, h0 << 16), a0[1] - __builtin_bit_cast(float, h1 << 16)); lv.y = pk2(a0[2] - __builtin_bit_cast(float, h2 << 16), a0[3] - __builtin_bit_cast(float, h3 << 16));
                lv.z = pk2(a1[0] - __builtin_bit_cast(float, h4 << 16), a1[1] - __builtin_bit_cast(float, h5 << 16)); lv.w = pk2(a1[2] - __builtin_bit_cast(float, h6 << 16), a1[3] - __builtin_bit_cast(float, h7 << 16));
                kh[t2][ks] = __builtin_bit_cast(bf16x8, hv); kl[t2][ks] = __builtin_bit_cast(bf16x8, lv); }
        volatile LAS unsigned* cloc = (volatile LAS unsigned*)(F.lds + F.wave * 256);
        if (F.lane < 32) cloc[F.lane] = 0u;
        LDS_WAIT();
        int pend[4][3];
#pragma unroll
        for (int tile = 0; tile < 4; ++tile) {
            const int tpos = t0 + tile * 16 + n16, row = b * SEQ + tpos;
            bf16x8 qf[4];
#pragma unroll
            for (int ks = 0; ks < 4; ++ks) qf[ks] = *(const bf16x8*)(Pb + (size_t)row * INC + h * 128 + 32 * ks + 8 * g);
            f32x4 acc[2];
#pragma unroll
            for (int t2 = 0; t2 < 2; ++t2) { acc[t2] = (f32x4){0.f, 0.f, 0.f, 0.f};
#pragma unroll
                for (int ks = 0; ks < 4; ++ks) { acc[t2] = __builtin_amdgcn_mfma_f32_16x16x32_bf16(kh[t2][ks], qf[ks], acc[t2], 0, 0, 0);
                    acc[t2] = __builtin_amdgcn_mfma_f32_16x16x32_bf16(kl[t2][ks], qf[ks], acc[t2], 0, 0, 0); } }
            Top3 t; t.v0 = t.v1 = t.v2 = -INFINITY; t.i0 = 64; t.i1 = 65; t.i2 = 66;
#pragma unroll
            for (int t2 = 0; t2 < 2; ++t2)
#pragma unroll
                for (int i = 0; i < 4; ++i) { const int blk = 16 * t2 + 4 * g + i; t3_insert(t, blk < own ? acc[t2][i] : -INFINITY, blk); }
#pragma unroll
            for (int x = 16; x <= 32; x <<= 1) {
                const float p0 = __shfl_xor(t.v0, x), p1 = __shfl_xor(t.v1, x), p2 = __shfl_xor(t.v2, x);
                const int q0 = __shfl_xor(t.i0, x), q1 = __shfl_xor(t.i1, x), q2 = __shfl_xor(t.i2, x);
                t3_insert(t, p0, q0); t3_insert(t, p1, q1); t3_insert(t, p2, q2);
            }
            pend[tile][0] = pend[tile][1] = pend[tile][2] = -1;
            if (g == 0) {
                const int s0 = t.v0 > -INFINITY ? t.i0 : -1, s1 = t.v1 > -INFINITY ? t.i1 : -1, s2 = t.v2 > -INFINITY ? t.i2 : -1;
                sel[(size_t)(row * 8 + h) * 4] = (s0 & 0xff) | ((s1 & 0xff) << 8) | ((s2 & 0xff) << 16);
                if (s0 >= 0) pend[tile][0] = (s0 << 16) | (int)__hip_atomic_fetch_add((LAS unsigned*)cloc + s0, 1u, __ATOMIC_RELAXED, __HIP_MEMORY_SCOPE_WORKGROUP);
                if (s1 >= 0) pend[tile][1] = (s1 << 16) | (int)__hip_atomic_fetch_add((LAS unsigned*)cloc + s1, 1u, __ATOMIC_RELAXED, __HIP_MEMORY_SCOPE_WORKGROUP);
                if (s2 >= 0) pend[tile][2] = (s2 << 16) | (int)__hip_atomic_fetch_add((LAS unsigned*)cloc + s2, 1u, __ATOMIC_RELAXED, __HIP_MEMORY_SCOPE_WORKGROUP);
            }
        }
        LDS_WAIT();
        if (F.lane < 32) { const unsigned c = cloc[F.lane];
            cloc[32 + F.lane] = c ? __hip_atomic_fetch_add(lcnt + (bh * 32 + F.lane) * CPAD, c, __ATOMIC_RELAXED, __HIP_MEMORY_SCOPE_AGENT) : 0u; }
        LDS_WAIT();
        if (g == 0) {
#pragma unroll
            for (int tile = 0; tile < 4; ++tile)
#pragma unroll
                for (int k = 0; k < 3; ++k) { const int pe = pend[tile][k];
                    if (pe >= 0) { const int blk = pe >> 16; list[(size_t)(bh * 32 + blk) * 8192 + cloc[32 + blk] + (unsigned)(pe & 0xffff)] = ((t0 + tile * 16 + n16) << 2) | k; } }
        }
        LDS_WAIT();
    }
    for (int item = F.gw; item < (T / 32) * 4; item += F.NGW) {
        const int g = item & 3, row0 = (item >> 2) * 32, t0 = row0 & (SEQ - 1), w = 2 << g;
        const bf16_t* up = Pb + 4608 + g * 128 + 2 * F.lane;
        float s0 = 0.f, s1 = 0.f;
        const int nin = t0 < w ? t0 : w;
#pragma unroll
        for (int i = 0; i < 16; ++i) if (i < nin) { const unsigned u = *(const unsigned*)(up + (size_t)(row0 - 1 - i) * INC); s0 += bf_lo(u); s1 += bf_hi(u); }
#pragma unroll
        for (int i = 0; i < 32; ++i) { const int row = row0 + i, tpos = t0 + i;
            const unsigned ut = *(const unsigned*)(up + (size_t)row * INC);
            const int rold = tpos >= w ? row - w : row;
            const unsigned uo = *(const unsigned*)(up + (size_t)rold * INC);
            s0 += bf_lo(ut); s1 += bf_hi(ut);
            if (tpos >= w) { s0 -= bf_lo(uo); s1 -= bf_hi(uo); }
            const float inv = 1.0f / (float)(tpos + 1 < w ? tpos + 1 : w);
            *(unsigned*)(mix + (size_t)row * D + 1536 + g * 128 + 2 * F.lane) = pk2(s0 * inv - bf_lo(ut), s1 * inv - bf_hi(ut)); }
    }
    conv_moe(ap, F, l, 0, conv_moe_split(F.G, l), F.gw, F.NGW);
}
__device__ __forceinline__ void phase_attn_tiles(LAS unsigned char* lds, int l) {
    CArgsP ap = kargs(); Frame F = make_frame(lds); unsigned char* ws = ap->ws;
    const bf16_t* Pb = (const bf16_t*)(ws + WS_P); const int* list = (const int*)(ws + WS_SMALL + SM_LIST); const unsigned* lcnt = (const unsigned*)(ws + WS_CTL) + CW_LCNT + 512 * CPAD * l;
    bf16_t* OP = (bf16_t*)(ws + WS_OP); float* ML = (float*)(ws + WS_SMALL + SM_ML);
    LAS int* pre = (LAS int*)(F.lds + MISC_OFF + 1024);
    LAS int* tmp = (LAS int*)F.lds;
    tmp[F.tid] = 1 + (int)((lcnt[F.tid * CPAD] + 255u) >> 8);
    __syncthreads();
    { int sum = 0; for (int k = 0; k < F.tid; ++k) sum += tmp[k]; pre[F.tid] = sum; if (F.tid == 511) pre[512] = sum + tmp[511]; }
    __syncthreads();
    const int n_moba = pre[512], n_total = n_moba + 1536;
    const int n = F.lane & 15;
    const int vb = (F.G & 7) == 0 ? ((int)blockIdx.x & 7) * (F.G >> 3) + ((int)blockIdx.x >> 3) : (int)blockIdx.x;
    for (int t = vb; t < n_moba; t += F.G) {
        int lo_i = 0, hi_i = 512;
        while (hi_i - lo_i > 1) { const int mid = (lo_i + hi_i) >> 1; if (pre[mid] <= t) lo_i = mid; else hi_i = mid; }
        const int li = lo_i, ti = t - pre[li];
        const int b = li >> 8, h = (li >> 5) & 7, j = li & 31;
        stage_kv(F.lds, Pb + 1024 + h * 128, Pb + 2048 + h * 128, INC, b * SEQ + j * 256, 1, 0, F.tid);
        const float slope2 = alibi_slope(h + (h >> 1)) * LOG2E;
        const int cntl = (int)lcnt[li * CPAD];
        __syncthreads();
#pragma unroll 1
        for (int sb = 0; sb < 2; ++sb) {
            int tpos, slot; bool qv = true;
            if (ti == 0) { tpos = j * 256 + sb * 128 + F.wave * 16 + n; slot = 3; }
            else { int idx = (ti - 1) * 256 + sb * 128 + F.wave * 16 + n; qv = idx < cntl; idx = qv ? idx : cntl - 1;
                const int e = list[(size_t)li * 8192 + idx]; tpos = e >> 2; slot = e & 3; }
            if (ti > 0 && (ti - 1) * 256 + sb * 128 >= cntl) break;
            const int row = b * SEQ + tpos;
            const size_t pslot = ((size_t)row * 12 + h) * 4 + slot;
            attn_tile_wave<8, true>(F.lds, 0, Pb + (size_t)row * INC + h * 128, ATT_SCALE * LOG2E, (float)(tpos - j * 256), 1.0e9f, 0.f, slope2, ti == 0, OP + pslot * 64, ML + pslot * 2, qv, F.lane);
        }
        __syncthreads();
    }
    int d0 = (vb - n_moba) % F.G; if (d0 < 0) d0 += F.G;
    for (int d = d0; d < 1536; d += F.G) {
        const int idx64 = d & 63, rest = d >> 6, br = rest % 3, bh = rest / 3, hb = bh & 3, b = bh >> 2;
        const int dil = 1 << (2 * br), nb = 64 >> (2 * br);
        const int r = idx64 / nb, cb = idx64 - r * nb;
        stage_kv(F.lds, Pb + 3584 + hb * 128, Pb + 4096 + hb * 128, INC, b * SEQ + (128 * cb - 128) * dil + r, dil, b * SEQ, F.tid);
        const int tpos = (128 * cb + 16 * F.wave + n) * dil + r, row = b * SEQ + tpos;
        const float slope2 = alibi_slope(3 * hb + 2) * (float)dil * LOG2E;
        const size_t pslot = ((size_t)row * 12 + 8 + hb) * 4 + br;
        __syncthreads();
        attn_tile_wave<5, true>(F.lds, F.wave >> 1, Pb + (size_t)row * INC + 3072 + hb * 128, ATT_SCALE * LOG2E, (float)(128 + 16 * F.wave + n), 128.f, cb == 0 ? 128.f : 0.f, slope2, true,
                          OP + pslot * 64, ML + pslot * 2, true, F.lane);
        __syncthreads();
    }
}
__device__ __forceinline__ void phase_attn_combine(LAS unsigned char* lds, int l) {
    CArgsP ap = kargs(); Frame F = make_frame(lds); unsigned char* ws = ap->ws;
    const bf16_t* OP = (const bf16_t*)(ws + WS_OP); const float* ML = (const float*)(ws + WS_SMALL + SM_ML); const int* sel = (const int*)(ws + WS_SMALL + SM_SEL);
    bf16_t* mix = (bf16_t*)(ws + WS_MIX);
    const int sub = F.lane & 15, grp = F.lane >> 4;
#pragma unroll 4
    for (int item = F.gw; item < T * 3; item += F.NGW) {
        const int idx = item * 4 + grp, row = idx / 12, hh = idx - row * 12;
        const bool moba = hh < 8;
        const int selw = moba ? sel[(size_t)(row * 8 + hh) * 4] : 0;
        f32x2 mlv[4]; u32x2 uu[4];
#pragma unroll
        for (int sidx = 0; sidx < 4; ++sidx) { mlv[sidx] = (f32x2){0.f, 0.f}; uu[sidx] = (u32x2){0u, 0u};
            if (moba || sidx < 3) { mlv[sidx] = *(const f32x2*)(ML + ((size_t)idx * 4 + sidx) * 2); uu[sidx] = *(const u32x2*)((const unsigned char*)OP + ((size_t)idx * 4 + sidx) * 128 + sub * 8); } }
        bool val[4]; float mm[4], ll[4];
#pragma unroll
        for (int sidx = 0; sidx < 4; ++sidx) {
            const bool v = moba ? ((sidx == 3) ? true : (((selw >> (8 * sidx)) & 0xff) != 0xff)) : sidx < 3;
            val[sidx] = v; mm[sidx] = v ? mlv[sidx].x : -INFINITY; ll[sidx] = v ? mlv[sidx].y : 0.f;
        }
        const float M = fmaxf(fmaxf(mm[0], mm[1]), fmaxf(mm[2], mm[3]));
        float wsum = 0.f, wgt[4];
#pragma unroll
        for (int sidx = 0; sidx < 4; ++sidx) { wgt[sidx] = val[sidx] ? ll[sidx] * __builtin_amdgcn_exp2f(mm[sidx] - M) : 0.f; wsum += wgt[sidx]; }
        const float inv = 1.0f / wsum;
        float o[8] = {0.f, 0.f, 0.f, 0.f, 0.f, 0.f, 0.f, 0.f};
#pragma unroll
        for (int sidx = 0; sidx < 4; ++sidx) { const u32x2 u = uu[sidx]; const float w = wgt[sidx] * inv * (1.0f / 16.0f);
            const f32x2 a = __builtin_amdgcn_cvt_pk_f32_fp8((int)u.x, false), b = __builtin_amdgcn_cvt_pk_f32_fp8((int)u.x, true), c = __builtin_amdgcn_cvt_pk_f32_fp8((int)u.y, false), d = __builtin_amdgcn_cvt_pk_f32_fp8((int)u.y, true);
            o[0] += w * a.x; o[1] += w * a.y; o[2] += w * b.x; o[3] += w * b.y; o[4] += w * c.x; o[5] += w * c.y; o[6] += w * d.x; o[7] += w * d.y; }
        const int D0 = 32 * (sub & 3) + 4 * (sub >> 2);
        u32x2 wa, wb; wa.x = pk2(o[0], o[1]); wa.y = pk2(o[2], o[3]); wb.x = pk2(o[4], o[5]); wb.y = pk2(o[6], o[7]);
        *(u32x2*)(mix + (size_t)row * D + hh * 128 + D0) = wa; *(u32x2*)(mix + (size_t)row * D + hh * 128 + D0 + 16) = wb;
    }
}
__device__ __forceinline__ void phase_outproj(LAS unsigned char* lds, int l) {
    CArgsP ap = kargs(); unsigned char* ws = ap->ws; const int G = gridDim.x;
    pg8::Gemm g{(const bf16_t*)(ws + WS_MIX), (const bf16_t*)(ws + WS_WOUT) + (size_t)l * D * D, T, D, D}; pg8::StaticOrder S; S.init(T, D, G, (int)blockIdx.x);
    pg8::EpiRes E{(bf16_t*)(ws + WS_XB), (float*)(ws + WS_SMALL + SM_SSQP), nullptr};
    pg8::gemm_phase<pg8::EpiRes, pg8::StaticOrder>(lds, g, S, E);
}
__device__ __forceinline__ void phase_memq(LAS unsigned char* lds, int l) {
    CArgsP ap = kargs(); unsigned char* ws = ap->ws; const int G = gridDim.x;
    pg8::Gemm g{(const bf16_t*)(ws + WS_XB), (const bf16_t*)(ws + WS_WC) + (size_t)(l ? 2560 : 0) * D, T, 512, D}; pg8::P7Order S{G, (int)blockIdx.x, 128, l == 0 ? 16 : 0};
    pg8::EpiP7 E{(bf16_t*)(ws + WS_QC), (bf16_t*)(ws + WS_KVC), (const float*)(ws + WS_SMALL + SM_RSALL)};
    pg8::gemm_phase<pg8::EpiP7, pg8::P7Order>(lds, g, S, E);
    const int nb = memq_busy(l);
    if ((int)blockIdx.x >= nb) { Frame F = make_frame(lds); conv_moe(ap, F, l, conv_moe_split(G, l), CONV_MOE_ITEMS, ((int)blockIdx.x - nb) * 8 + F.wave, (G - nb) * 8); }
}
__device__ __forceinline__ void phase_cross(LAS unsigned char* lds, int l) {
    CArgsP ap = kargs(); Frame F = make_frame(lds); unsigned char* ws = ap->ws;
    const bf16_t* qc = (const bf16_t*)(ws + WS_QC); bf16_t* oc = (bf16_t*)(ws + WS_OC); const float* ssqp = (const float*)(ws + WS_SMALL + SM_SSQP);
    const bf16_t* Kb = (const bf16_t*)(ws + WS_KVC) + (size_t)l * 512 * 1024;
    const int n = F.lane & 15;
    int staged = -1;
    for (int t = blockIdx.x; t < 512; t += F.G) {
        const int bh = t & 7, qt = t >> 3, b = bh >> 2, h = bh & 3;
        if (bh != staged) { __syncthreads(); stage_kv(F.lds, Kb + h * 128, Kb + 512 + h * 128, 1024, b * 256, 1, 0, F.tid); staged = bh; __syncthreads(); }
        const int row = b * SEQ + qt * 128 + F.wave * 16 + n;
        float ss = 0.f;
#pragma unroll
        for (int i = 0; i < 8; ++i) { const f32x4 pv = *(const f32x4*)(ssqp + (size_t)row * 32 + 4 * i); ss += (pv[0] + pv[1]) + (pv[2] + pv[3]); }
        const float rs = 1.0f / sqrtf(ss * (1.0f / D) + RMS_EPS);
        attn_tile_wave<8, false>(F.lds, 0, qc + (size_t)row * 512 + h * 128, ATT_SCALE * LOG2E * rs, 1.0e6f, 1.0e9f, 0.f, 0.f, false, oc + (size_t)row * 512 + h * 128, nullptr, true, F.lane);
    }
    __syncthreads();
}
__device__ __forceinline__ void phase_memo(LAS unsigned char* lds, int l) {
    CArgsP ap = kargs(); unsigned char* ws = ap->ws; const int G = gridDim.x;
    pg8::Gemm g{(const bf16_t*)(ws + WS_OC), (const bf16_t*)(ws + WS_WMO) + (size_t)l * D * 512, T, D, 512}; pg8::StaticOrder S; S.init(T, D, G, (int)blockIdx.x);
    pg8::EpiRes E{(bf16_t*)(ws + WS_XB), (float*)(ws + WS_SMALL + SM_SSQP), ws + WS_X8};
    pg8::gemm_phase<pg8::EpiRes, pg8::StaticOrder>(lds, g, S, E);
}
__device__ __forceinline__ void phase_router(LAS unsigned char* lds, int l) {
    CArgsP ap = kargs(); Frame F = make_frame(lds); unsigned char* ws = ap->ws;
    const bf16_t* xbp = (const bf16_t*)(ws + WS_XB); const float* wrt = (const float*)(ws + WS_SMALL + SM_WRT) + (size_t)l * 48 * D;
    int* tok_e = (int*)(ws + WS_SMALL + SM_TOKE); int* tok_rank = (int*)(ws + WS_SMALL + SM_TOKRANK); float* tok_w = (float*)(ws + WS_SMALL + SM_TOKW); float* rs3 = (float*)(ws + WS_SMALL + SM_RS3);
    unsigned* cnt = (unsigned*)(ws + WS_CTL) + CW_CNT + 32 * CPAD * l;
    const float* bg = ap->in[I_BGROUP] + l * 4; const float* br = ap->in[I_BROUTER] + l * 32;
    const int w8 = F.wave, tl = F.wave & 3, r16 = F.lane & 15, q = F.lane >> 4;
    constexpr int PLS = 16 * 49 + 16;
    LAS float* Pw = (LAS float*)F.lds + (w8 * 4) * PLS;
    for (int base = blockIdx.x * 64; base < T; base += F.G * 64) {
        const bf16_t* xa = xbp + (size_t)(base + r16) * D + w8 * 256 + 4 * q;
        const float* wb = wrt + (size_t)r16 * D + w8 * 256 + 4 * q;
        f32x4 acc[4][3]; float ssq[4];
#pragma unroll
        for (int rt = 0; rt < 4; ++rt) { ssq[rt] = 0.f; acc[rt][0] = acc[rt][1] = acc[rt][2] = (f32x4){0.f, 0.f, 0.f, 0.f}; }
        u32x2 abr[2][2][4]; f32x4 br_[2][2][3];
#define RT_LOAD(buf, u0) do { _Pragma("unroll") for (int i_ = 0; i_ < 2; ++i_) { const int u_ = (u0) + i_; \
            _Pragma("unroll") for (int ct = 0; ct < 3; ++ct) br_[buf][i_][ct] = *(const f32x4*)(wb + (size_t)(16 * ct) * D + 16 * u_); \
            _Pragma("unroll") for (int rt = 0; rt < 4; ++rt) abr[buf][i_][rt] = *(const u32x2*)(xa + (size_t)(16 * rt) * D + 16 * u_); } } while (0)
#define RT_MMA(buf) do { _Pragma("unroll") for (int i_ = 0; i_ < 2; ++i_) _Pragma("unroll") for (int rt = 0; rt < 4; ++rt) { const u32x2 ab = abr[buf][i_][rt]; \
            const f32x4 a = (f32x4){bf_lo(ab.x), bf_hi(ab.x), bf_lo(ab.y), bf_hi(ab.y)}; ssq[rt] += (a[0] * a[0] + a[1] * a[1]) + (a[2] * a[2] + a[3] * a[3]); \
            _Pragma("unroll") for (int j = 0; j < 4; ++j) _Pragma("unroll") for (int ct = 0; ct < 3; ++ct) acc[rt][ct] = __builtin_amdgcn_mfma_f32_16x16x4f32(a[j], br_[buf][i_][ct][j], acc[rt][ct], 0, 0, 0); } } while (0)
        RT_LOAD(0, 0);
#pragma unroll 1
        for (int ug = 0; ug < 8; ug += 2) {
            RT_LOAD(1, 2 * ug + 2);
            __builtin_amdgcn_sched_barrier(0);
            RT_MMA(0);
            __builtin_amdgcn_sched_barrier(0);
            if (ug + 2 < 8) RT_LOAD(0, 2 * ug + 4);
            __builtin_amdgcn_sched_barrier(0);
            RT_MMA(1);
            __builtin_amdgcn_sched_barrier(0);
        }
#undef RT_LOAD
#undef RT_MMA
#pragma unroll
        for (int rt = 0; rt < 4; ++rt) { float sq = ssq[rt]; sq += __shfl_xor(sq, 16); sq += __shfl_xor(sq, 32);
            LAS float* Pl = Pw + rt * PLS;
#pragma unroll
            for (int ct = 0; ct < 3; ++ct)
#pragma unroll
                for (int i = 0; i < 4; ++i) Pl[(4 * q + i) * 49 + 16 * ct + r16] = acc[rt][ct][i];
            if (q == 0) Pl[16 * 49 + r16] = sq; }
        __syncthreads();
        if (F.wave < 4 && F.lane < 16) {
            const LAS float* P0 = (const LAS float*)F.lds + tl * PLS;
            const int row = base + tl * 16 + F.lane;
            float sst = 0.f;
#pragma unroll
            for (int w = 0; w < 8; ++w) sst += P0[w * 4 * PLS + 16 * 49 + F.lane];
            const float rs = 1.0f / sqrtf(sst * (1.0f / D) + RMS_EPS);
            const LAS float* a0 = P0 + F.lane * 49;
#define RT_SUM(c_) (((a0[(c_)] + a0[4 * PLS + (c_)]) + (a0[8 * PLS + (c_)] + a0[12 * PLS + (c_)])) + ((a0[16 * PLS + (c_)] + a0[20 * PLS + (c_)]) + (a0[24 * PLS + (c_)] + a0[28 * PLS + (c_)])))
            float gl[4];
#pragma unroll
            for (int j = 0; j < 4; ++j) gl[j] = RT_SUM(j) * rs + bg[j];
            int gsel = 0; float gmax = gl[0];
#pragma unroll
            for (int j = 1; j < 4; ++j) if (gl[j] > gmax) { gmax = gl[j]; gsel = j; }
            float gden = 0.f;
#pragma unroll
            for (int j = 0; j < 4; ++j) gden += __expf(gl[j] - gmax);
            const float gwt = 1.0f / gden;
            float el[8];
#pragma unroll
            for (int j = 0; j < 8; ++j) el[j] = RT_SUM(4 + gsel * 8 + j) * rs + br[gsel * 8 + j];
            float v0 = el[0]; int i0 = 0;
#pragma unroll
            for (int j = 1; j < 8; ++j) if (el[j] > v0) { v0 = el[j]; i0 = j; }
            float v1 = -INFINITY; int i1 = 0;
#pragma unroll
            for (int j = 0; j < 8; ++j) if (j != i0 && el[j] > v1) { v1 = el[j]; i1 = j; }
            const float p0 = 1.0f / (1.0f + __expf(v1 - v0)), p1 = 1.0f - p0;
            const int e0 = gsel * 8 + i0, e1 = gsel * 8 + i1;
            const unsigned k0 = __hip_atomic_fetch_add(cnt + e0 * CPAD, 1u, __ATOMIC_RELAXED, __HIP_MEMORY_SCOPE_AGENT);
            const unsigned k1 = __hip_atomic_fetch_add(cnt + e1 * CPAD, 1u, __ATOMIC_RELAXED, __HIP_MEMORY_SCOPE_AGENT);
            tok_e[row * 2] = e0; tok_e[row * 2 + 1] = e1; tok_rank[row * 2] = (int)k0; tok_rank[row * 2 + 1] = (int)k1;
            tok_w[row * 2] = p0 * gwt; tok_w[row * 2 + 1] = p1 * gwt; rs3[row] = rs;
#undef RT_SUM
        }
        __syncthreads();
    }
}
__device__ __forceinline__ void phase_scatter(LAS unsigned char* lds, int l) {
    CArgsP ap = kargs(); Frame F = make_frame(lds); unsigned char* ws = ap->ws;
    const int* tok_e = (const int*)(ws + WS_SMALL + SM_TOKE); const int* tok_rank = (const int*)(ws + WS_SMALL + SM_TOKRANK); const float* tok_w = (const float*)(ws + WS_SMALL + SM_TOKW);
    const float* rs3 = (const float*)(ws + WS_SMALL + SM_RS3); int* tokrow = (int*)(ws + WS_SMALL + SM_TOKROW); f32x4* rowinfo = (f32x4*)(ws + WS_SMALL + SM_ROWINFO);
    int* panel_e = (int*)(ws + WS_SMALL + SM_PANEL); unsigned* cnt = (unsigned*)(ws + WS_CTL) + CW_CNT + 32 * CPAD * l;
    const bf16_t* xb = (const bf16_t*)(ws + WS_XB); bf16_t* XG = (bf16_t*)(ws + WS_P);
    LAS int* offs = (LAS int*)F.lds;
    if (F.tid == 0) { int o = 0; for (int e = 0; e < 32; ++e) { const int c = (int)__hip_atomic_load(cnt + e * CPAD, __ATOMIC_RELAXED, __HIP_MEMORY_SCOPE_AGENT); offs[e] = o; offs[64 + e] = c; o += (c + 255) & ~255; } offs[32] = o; }
    __syncthreads();
    int* rowtok = (int*)(ws + WS_SMALL + SM_ROWTOK);
    for (int item = blockIdx.x * 512 + F.tid; item < T * 2; item += F.G * 512) {
        const int row = item >> 1;
        const int e = tok_e[item], rank = tok_rank[item]; const int pos = offs[e] + rank;
        rowinfo[pos] = (f32x4){__builtin_bit_cast(float, row), tok_w[item], rs3[row], 0.f}; tokrow[item] = pos; rowtok[pos] = row;
    }
    for (int idx = blockIdx.x * 512 + F.tid; idx < 32 * 256; idx += F.G * 512) {
        const int e = idx >> 8, r = idx & 255; const int pos = offs[e] + offs[64 + e] + r;
        if (pos < offs[e + 1]) { float z = 0.f; asm volatile("" : "+v"(z)); rowinfo[pos] = (f32x4){z, z, z, z}; rowtok[pos] = 0; }
    }
    if (blockIdx.x == 0) {
        const int np = offs[32] >> 8;
        for (int p = F.tid; p < np; p += 512) { int e = 0;
            for (int k = 0; k < 32; ++k) if (offs[k] <= p * 256 && p * 256 < offs[k + 1]) e = k;
            panel_e[p] = e; }
        if (F.tid == 0) panel_e[200] = np;
    }
    __syncthreads();
}
constexpr int MOE_G1 = 128, MOE_SKIP = 2;
__device__ __forceinline__ void phase_moe_a(LAS unsigned char* lds, int l) {
    CArgsP ap = kargs(); unsigned char* ws = ap->ws; const int G = gridDim.x;
    const int* panel_e = (const int*)(ws + WS_SMALL + SM_PANEL);
    const int np = __builtin_amdgcn_readfirstlane(panel_e[200]); const int n1 = np < MOE_G1 ? np : MOE_G1;
    pg8::Gemm g{(const bf16_t*)(ws + WS_X8), (const bf16_t*)(ws + WS_W13), MAXROWS, 32 * 1024, D / 2}; pg8::GroupedOrder S{G, (int)blockIdx.x, 4, panel_e, 0, n1};
    pg8::EpiMoe1 E{ws + WS_H, (const f32x4*)(ws + WS_SMALL + SM_ROWINFO), 1.0f / (X8_SCALE * W8_SCALE)};
    pg8::gemm_phase_gather<pg8::EpiMoe1, pg8::GroupedOrder, true>(lds, g, S, E, (const int*)(ws + WS_SMALL + SM_ROWTOK));
}
__device__ __forceinline__ void phase_moe_b(LAS unsigned char* lds, int l) {
    CArgsP ap = kargs(); unsigned char* ws = ap->ws; const int G = gridDim.x;
    const int* panel_e = (const int*)(ws + WS_SMALL + SM_PANEL);
    const int np = __builtin_amdgcn_readfirstlane(panel_e[200]); const int n1 = np < MOE_G1 ? np : MOE_G1, n2 = np - n1;
    int nlong = n2 * 4; if (nlong > G) nlong = G;
    if (n2 * 4 <= G) {
        pg8::Gemm g{(const bf16_t*)(ws + WS_X8), (const bf16_t*)(ws + WS_W13), MAXROWS, 32 * 1024, D / 2}; pg8::OneUnitOrder S{(int)blockIdx.x, 4, panel_e, n1, n2 * 4};
        pg8::EpiMoe1 E{ws + WS_H, (const f32x4*)(ws + WS_SMALL + SM_ROWINFO), 1.0f / (X8_SCALE * W8_SCALE)};
        pg8::gemm_phase_gather<pg8::EpiMoe1, pg8::OneUnitOrder, true>(lds, g, S, E, (const int*)(ws + WS_SMALL + SM_ROWTOK));
    } else {
        pg8::Gemm g{(const bf16_t*)(ws + WS_X8), (const bf16_t*)(ws + WS_W13), MAXROWS, 32 * 1024, D / 2}; pg8::GroupedOrder S{G, (int)blockIdx.x, 4, panel_e, n1, n2};
        pg8::EpiMoe1 E{ws + WS_H, (const f32x4*)(ws + WS_SMALL + SM_ROWINFO), 1.0f / (X8_SCALE * W8_SCALE)};
        pg8::gemm_phase_gather<pg8::EpiMoe1, pg8::GroupedOrder, true>(lds, g, S, E, (const int*)(ws + WS_SMALL + SM_ROWTOK));
    }
    __syncthreads();
    {
        pg8::Gemm g{(const bf16_t*)(ws + WS_H), (const bf16_t*)(ws + WS_W2), MAXROWS, 32 * D, 256}; pg8::GroupedSkewOrder S{G, (int)blockIdx.x, 8, panel_e, n1, nlong, MOE_SKIP};
        pg8::EpiMoe2 E{(bf16_t*)(ws + WS_P), 1.0f / (H8_SCALE * W28_SCALE)};
        pg8::gemm_phase<pg8::EpiMoe2, pg8::GroupedSkewOrder, true>(lds, g, S, E);
    }
}
__device__ __forceinline__ void phase_moe_c(LAS unsigned char* lds, int l) {
    CArgsP ap = kargs(); unsigned char* ws = ap->ws; const int G = gridDim.x;
    const int* panel_e = (const int*)(ws + WS_SMALL + SM_PANEL);
    const int np = __builtin_amdgcn_readfirstlane(panel_e[200]); const int n1 = np < MOE_G1 ? np : MOE_G1, n2 = np - n1;
    pg8::Gemm g{(const bf16_t*)(ws + WS_H), (const bf16_t*)(ws + WS_W2), MAXROWS, 32 * D, 256}; pg8::GroupedOrder S{G, (int)blockIdx.x, 8, panel_e, n1, n2};
    pg8::EpiMoe2 E{(bf16_t*)(ws + WS_P), 1.0f / (H8_SCALE * W28_SCALE)};
    pg8::gemm_phase<pg8::EpiMoe2, pg8::GroupedOrder, true>(lds, g, S, E);
}
__device__ __forceinline__ void phase_combine(LAS unsigned char* lds, int l) {
    CArgsP ap = kargs(); Frame F = make_frame(lds); unsigned char* ws = ap->ws;
    bf16_t* xb = (bf16_t*)(ws + WS_XB); float* rs_all = (float*)(ws + WS_SMALL + SM_RSALL);
    const int* tokrow = (const int*)(ws + WS_SMALL + SM_TOKROW); const bf16_t* YG = (const bf16_t*)(ws + WS_P);
    const float* gfin = ap->in[I_GFINAL]; float* outp = ap->out;
    for (int row = F.gw; row < T; row += F.NGW) {
        const int r0 = tokrow[row * 2], r1 = tokrow[row * 2 + 1];
        float v[4][8]; float ss = 0.f;
#pragma unroll
        for (int i = 0; i < 4; ++i) { const int c0 = 8 * F.lane + 512 * i;
            const u32x4 xa = *(const u32x4*)(xb + (size_t)row * D + c0), ya = *(const u32x4*)(YG + (size_t)r0 * D + c0), yb = *(const u32x4*)(YG + (size_t)r1 * D + c0);
            v[i][0] = bf_lo(xa.x) + bf_lo(ya.x) + bf_lo(yb.x); v[i][1] = bf_hi(xa.x) + bf_hi(ya.x) + bf_hi(yb.x);
            v[i][2] = bf_lo(xa.y) + bf_lo(ya.y) + bf_lo(yb.y); v[i][3] = bf_hi(xa.y) + bf_hi(ya.y) + bf_hi(yb.y);
            v[i][4] = bf_lo(xa.z) + bf_lo(ya.z) + bf_lo(yb.z); v[i][5] = bf_hi(xa.z) + bf_hi(ya.z) + bf_hi(yb.z);
            v[i][6] = bf_lo(xa.w) + bf_lo(ya.w) + bf_lo(yb.w); v[i][7] = bf_hi(xa.w) + bf_hi(ya.w) + bf_hi(yb.w);
#pragma unroll
            for (int j = 0; j < 8; ++j) ss += v[i][j] * v[i][j]; }
        ss = wave_sum(ss);
        const float rs = 1.0f / sqrtf(ss * (1.0f / D) + RMS_EPS);
        if (l == 1) {
#pragma unroll
            for (int i = 0; i < 4; ++i) { const int c0 = 8 * F.lane + 512 * i; const f32x4 g0 = *(const f32x4*)(gfin + c0), g1 = *(const f32x4*)(gfin + c0 + 4);
                *(f32x4*)(outp + (size_t)row * D + c0) = (f32x4){v[i][0] * rs * g0[0], v[i][1] * rs * g0[1], v[i][2] * rs * g0[2], v[i][3] * rs * g0[3]};
                *(f32x4*)(outp + (size_t)row * D + c0 + 4) = (f32x4){v[i][4] * rs * g1[0], v[i][5] * rs * g1[1], v[i][6] * rs * g1[2], v[i][7] * rs * g1[3]}; }
        } else {
            if (F.lane == 0) rs_all[row] = rs;
#pragma unroll
            for (int i = 0; i < 4; ++i) { const int c0 = 8 * F.lane + 512 * i;
                u32x4 w; w.x = pk2(v[i][0], v[i][1]); w.y = pk2(v[i][2], v[i][3]); w.z = pk2(v[i][4], v[i][5]); w.w = pk2(v[i][6], v[i][7]);
                *(u32x4*)(xb + (size_t)row * D + c0) = w;
                u32x2 q8; q8.x = pk4f8((f32x4){v[i][0], v[i][1], v[i][2], v[i][3]} * X8_SCALE); q8.y = pk4f8((f32x4){v[i][4], v[i][5], v[i][6], v[i][7]} * X8_SCALE);
                *(u32x2*)(ws + WS_XI8 + (size_t)row * D + c0) = q8; }
        }
    }
}

constexpr int NPL = 14;
constexpr int NPH = 1 + 2 * NPL;
#ifndef DBG_MASK
#define DBG_MASK 0x7fff
#endif
#define PHEN(j) (((DBG_MASK) >> (j)) & 1)

__global__ void __launch_bounds__(512, 2) fwd(Args args) {
    extern __shared__ __attribute__((aligned(16))) unsigned char lds_raw[];
    LAS unsigned char* lds = (LAS unsigned char*)lds_raw;
    volatile LAS unsigned* MISC = (volatile LAS unsigned*)(lds + MISC_OFF);
    if (threadIdx.x < 64) MISC[threadIdx.x] = 0u;
    __syncthreads();
    const int lo = args.ph_lo, hi = args.ph_hi;
    unsigned* barw = (unsigned*)(args.ws + WS_CTL) + CW_BAR + args.li * XCD_BAR_WORDS;
    XcdBarrier bar; bar.bar = barw; bar.x = 0; bar.st = MISC + 8;
    if (hi - lo > 1) bar = xcd_barrier_post(barw, MISC + 8);
#define IN(k) (lo <= (k) && (k) < hi)
#define SEAM(k) do { if (IN(k) && IN((k) + 1)) xcd_barrier(bar); } while (0)

    if (PHEN(0) && IN(0)) phase_prologue(lds);
    SEAM(0);
    for (int l = 0; l < 2; ++l) {
        const int pb = 1 + NPL * l;
        if (PHEN(1) && IN(pb + 0)) phase_inproj(lds, l);
        SEAM(pb + 0);
        if (PHEN(2) && IN(pb + 1)) phase_gate(lds, l);
        SEAM(pb + 1);
        if (PHEN(3) && IN(pb + 2)) phase_attn_tiles(lds, l);
        SEAM(pb + 2);
        if (PHEN(4) && IN(pb + 3)) phase_attn_combine(lds, l);
        SEAM(pb + 3);
        if (PHEN(5) && IN(pb + 4)) phase_outproj(lds, l);
        SEAM(pb + 4);
        if (PHEN(6) && IN(pb + 5)) phase_memq(lds, l);
        SEAM(pb + 5);
        if (PHEN(7) && IN(pb + 6)) phase_cross(lds, l);
        SEAM(pb + 6);
        if (PHEN(8) && IN(pb + 7)) phase_memo(lds, l);
        SEAM(pb + 7);
        if (PHEN(9) && IN(pb + 8)) phase_router(lds, l);
        SEAM(pb + 8);
        if (PHEN(10) && IN(pb + 9)) phase_scatter(lds, l);
        SEAM(pb + 9);
        if (PHEN(11) && IN(pb + 10)) phase_moe_a(lds, l);
        SEAM(pb + 10);
        if (PHEN(12) && IN(pb + 11)) phase_moe_b(lds, l);
        SEAM(pb + 11);
        if (PHEN(13) && IN(pb + 12)) phase_moe_c(lds, l);
        SEAM(pb + 12);
        if (PHEN(14) && IN(pb + 13)) phase_combine(lds, l);
        SEAM(pb + 13);
    }
#undef IN
#undef SEAM
}

extern "C" void kernel_launch(void* const* d_in, const int* in_sizes, int n_in, void* d_out, int out_size, void* d_ws, size_t ws_size, hipStream_t stream) {
    static int grid = 0;
    if (grid == 0) {
        if (n_in != N_IN || in_sizes[0] != T * D || out_size != T * D || ws_size < WS_END) { fprintf(stderr, "kernel_launch: unexpected shapes (n_in %d in0 %d out %d ws %zu need %zu)\n", n_in, n_in > 0 ? in_sizes[0] : -1, out_size, ws_size, (size_t)WS_END); grid = -1; return; }
        int dev = 0, cus = 0, per_cu = 0;
        if (hipGetDevice(&dev) != hipSuccess || hipDeviceGetAttribute(&cus, hipDeviceAttributeMultiprocessorCount, dev) != hipSuccess) { grid = -1; return; }
        if (hipFuncSetAttribute((const void*)fwd, hipFuncAttributeMaxDynamicSharedMemorySize, LDS_BYTES) != hipSuccess) { fprintf(stderr, "kernel_launch: hipFuncSetAttribute failed\n"); grid = -1; return; }
        if (hipOccupancyMaxActiveBlocksPerMultiprocessor(&per_cu, (const void*)fwd, 512, LDS_BYTES) != hipSuccess || per_cu < 1) fprintf(stderr, "kernel_launch: occupancy query reports %d\n", per_cu);
        (void)hipGetLastError();
        grid = cus;
    }
    if (grid < 0) return;
    if (hipMemsetAsync((char*)d_ws + WS_CTL, 0, CTL_ZERO_BYTES, stream) != hipSuccess) { fprintf(stderr, "kernel_launch: memset failed\n"); return; }
    Args a{};
    for (int i = 0; i < N_IN; ++i) a.in[i] = (const float*)d_in[i];
    a.out = (float*)d_out; a.ws = (unsigned char*)d_ws; a.pad = 0;
#if MK_LAUNCH_PER_PHASE
    for (int ph = 0; ph < NPH; ++ph) { a.ph_lo = ph; a.ph_hi = ph + 1; a.li = 0;
        hipLaunchKernelGGL(fwd, dim3(grid), dim3(512), LDS_BYTES, stream, a);
        const hipError_t le = hipPeekAtLastError(); if (le != hipSuccess) { fprintf(stderr, "kernel_launch: launch %d failed: %s\n", ph, hipGetErrorName(le)); break; } }
#else
    a.ph_lo = 0; a.ph_hi = NPH; a.li = 0;
    hipLaunchKernelGGL(fwd, dim3(grid), dim3(512), LDS_BYTES, stream, a);
    const hipError_t le = hipPeekAtLastError(); if (le != hipSuccess) fprintf(stderr, "kernel_launch: launch failed: %s\n", hipGetErrorName(le));
#endif
}
```

```cpp
#include <hip/hip_runtime.h>
#include <cstdio>
#include <cstdint>

#ifndef MK_LAUNCH_PER_PHASE
#define MK_LAUNCH_PER_PHASE 0
#endif

#define LAS __attribute__((address_space(3)))
#define GAS __attribute__((address_space(1)))

typedef unsigned short bf16_t;
typedef short bf16x8 __attribute__((ext_vector_type(8)));
typedef float f32x4 __attribute__((ext_vector_type(4)));
typedef float f32x2 __attribute__((ext_vector_type(2)));
typedef unsigned u32x4 __attribute__((ext_vector_type(4)));
typedef unsigned u32x2 __attribute__((ext_vector_type(2)));
typedef int i32x4 __attribute__((ext_vector_type(4)));
typedef int i32x8 __attribute__((ext_vector_type(8)));

constexpr int T = 16384, D = 2048, SEQ = 8192, INC = 5120;
constexpr int NTOK_ALL = T + 512;
constexpr int MAXROWS = 40960;
constexpr float RMS_EPS = 1e-6f;
constexpr float ATT_SCALE = 0.08838834764831845f;

constexpr size_t MiB = 1u << 20;
constexpr size_t WS_CTL = 0, CTL_ZERO_BYTES = 160 * 1024;
constexpr size_t WS_XRES = 1 * MiB;
constexpr size_t WS_X8 = WS_XRES;
constexpr size_t WS_XI8 = WS_XRES + 32 * MiB;
constexpr size_t WS_WIN8 = WS_XRES + 64 * MiB;
constexpr size_t WS_XB = WS_XRES + 128 * MiB;
constexpr size_t WS_SMALL = WS_XB + 66 * MiB;
constexpr size_t WS_P = WS_SMALL + 32 * MiB;
constexpr size_t WS_MIX = WS_P + 160 * MiB;
constexpr size_t WS_QC = WS_MIX + 64 * MiB;
constexpr size_t WS_OC = WS_QC + 16 * MiB;
constexpr size_t WS_KVC = WS_OC + 16 * MiB;
constexpr size_t WS_H = WS_KVC + 2 * MiB;
constexpr size_t WS_WIN = WS_H + 40 * MiB;
constexpr size_t WS_WOUT = WS_WIN + 40 * MiB;
constexpr size_t WS_WC = WS_WOUT + 16 * MiB;
constexpr size_t WS_WMO = WS_WC + 12 * MiB;
constexpr size_t WS_W13 = WS_WMO + 4 * MiB;
constexpr size_t WS_W2 = WS_W13 + 128 * MiB;
constexpr size_t WS_OP = WS_W2 + 64 * MiB;
constexpr size_t WS_END = WS_OP + 192 * MiB;
constexpr size_t SM_RSALL = 0;
constexpr size_t SM_SSQP = 128 * 1024;
constexpr size_t SM_KMEAN = SM_SSQP + 2 * MiB;
constexpr size_t SM_SEL = SM_KMEAN + 256 * 1024;
constexpr size_t SM_TOKE = SM_SEL + 2 * MiB;
constexpr size_t SM_TOKRANK = SM_TOKE + 128 * 1024;
constexpr size_t SM_TOKW = SM_TOKRANK + 128 * 1024;
constexpr size_t SM_RS3 = SM_TOKW + 128 * 1024;
constexpr size_t SM_TOKROW = SM_RS3 + 64 * 1024;
constexpr size_t SM_ROWINFO = SM_TOKROW + 128 * 1024;
constexpr size_t SM_PANEL = SM_ROWINFO + 640 * 1024;
constexpr size_t SM_ML = 6 * MiB;
constexpr size_t SM_LIST = 12 * MiB;
constexpr size_t SM_ROWTOK = 5 * MiB + 768 * 1024;
constexpr size_t SM_WRT = 28 * MiB;
constexpr size_t SM_KMH = 29 * MiB;
static_assert((size_t)(4096 + 3456) * 4 <= 64 * 1024, "control words inside the per-call memset");
static_assert(SM_PANEL + 4096 <= SM_ROWTOK && SM_ROWTOK + 4 * MAXROWS <= SM_ML && SM_LIST + 16 * MiB <= 32 * MiB, "small tables");
constexpr int CPAD = 32;
constexpr int CW_CNT = 1024;
constexpr int CW_LCNT = 8192;
constexpr int CW_BAR = 4096;

constexpr int RING_BYTES = 131072;
constexpr int MISC_OFF = RING_BYTES;
constexpr int LDS_BYTES = 147456;

__device__ __forceinline__ unsigned f2bf(float f) { unsigned u = __builtin_bit_cast(unsigned, f); return (u + 0x7fffu + ((u >> 16) & 1u)) >> 16; }
__device__ __forceinline__ unsigned pk2(float lo, float hi) { unsigned r; asm("v_cvt_pk_bf16_f32 %0, %1, %2" : "=v"(r) : "v"(lo), "v"(hi)); return r; }
constexpr float H8_SCALE = 8.0f, W28_SCALE = 256.0f;
constexpr float X8_SCALE = 16.0f, W8_SCALE = 512.0f;
__device__ __forceinline__ float clamp8(float v) { return __builtin_fminf(__builtin_fmaxf(v, -448.0f), 448.0f); }
__device__ __forceinline__ unsigned pk4f8(f32x4 v) { int r = 0; r = __builtin_amdgcn_cvt_pk_fp8_f32(clamp8(v[0]), clamp8(v[1]), r, false); r = __builtin_amdgcn_cvt_pk_fp8_f32(clamp8(v[2]), clamp8(v[3]), r, true); return (unsigned)r; }
__device__ __forceinline__ float bf_lo(unsigned u) { return __builtin_bit_cast(float, u << 16); }
__device__ __forceinline__ float bf_hi(unsigned u) { return __builtin_bit_cast(float, u & 0xffff0000u); }
__device__ __forceinline__ float wave_sum(float v) {
#pragma unroll
    for (int o = 1; o < 64; o <<= 1) v += __shfl_xor(v, o);
    return v;
}
#define LDS_WAIT() asm volatile("s_waitcnt lgkmcnt(0)" ::: "memory")

#define XB_TMO      128
#define XB_XCNT(j)  (256  + 64 * (j))
#define XB_XSUB(j)  (1280 + 64 * (j))
#define XB_XGEN(j)  (2304 + 64 * (j))
#define XB_TOP      3328
#define XB_TOPGEN   3392
#define XCD_BAR_WORDS 3456
#define XB_SPIN_CAP (1u << 22)

__device__ __forceinline__ unsigned xb_ld(unsigned* p)              { return __hip_atomic_load(p, __ATOMIC_RELAXED, __HIP_MEMORY_SCOPE_AGENT); }
__device__ __forceinline__ unsigned xb_add(unsigned* p, unsigned v) { return __hip_atomic_fetch_add(p, v, __ATOMIC_RELAXED, __HIP_MEMORY_SCOPE_AGENT); }
__device__ __forceinline__ unsigned xb_xcc_id() { return (unsigned)__builtin_amdgcn_s_getreg((3 << 11) | 20) & 0xFu; }
#define XB_SPIN(cond, bar) do { unsigned _sp = 0; while (cond) { __builtin_amdgcn_s_sleep(1); \
    if ((++_sp & 255u) == 0u) { if (xb_ld(&(bar)[XB_TMO])) break; if (_sp > XB_SPIN_CAP) { atomicAdd(&(bar)[XB_TMO], 1u); break; } } } } while (0)

struct XcdBarrier { unsigned* bar; unsigned x; volatile LAS unsigned* st; };

__device__ __forceinline__ XcdBarrier xcd_barrier_post(unsigned* bar, volatile LAS unsigned* st) {
    XcdBarrier b; b.bar = bar; b.x = xb_xcc_id(); b.st = st;
    if (threadIdx.x == 0) (void)xb_add(&bar[XB_XCNT(b.x)], 1u);
    return b;
}
__device__ __forceinline__ void xcd_barrier_complete(unsigned* bar, unsigned x, unsigned& nloc, unsigned& nx) {
    const unsigned G = gridDim.x * gridDim.y * gridDim.z;
    unsigned sum, cnt, mine, sp = 0u;
    for (;;) {
        sum = 0u; cnt = 0u; mine = 0u;
#pragma unroll
        for (unsigned j = 0; j < 16; ++j) { const unsigned c = xb_ld(&bar[XB_XCNT(j)]); sum += c; cnt += (c > 0u) ? 1u : 0u; mine = (j == x) ? c : mine; }
        if (sum == G) break;
        __builtin_amdgcn_s_sleep(1);
        if ((++sp & 255u) == 0u) { if (xb_ld(&bar[XB_TMO])) break; if (sp > XB_SPIN_CAP) { atomicAdd(&bar[XB_TMO], 1u); break; } }
    }
    nloc = mine > 0u ? mine : 1u; nx = cnt > 0u ? cnt : 1u;
}
__device__ __forceinline__ void xcd_barrier(const XcdBarrier& b) {
    asm volatile("s_waitcnt vmcnt(0)" ::: "memory");
    __syncthreads();
    if (threadIdx.x == 0) {
        unsigned* bar = b.bar;
        __builtin_amdgcn_s_waitcnt(0);
        unsigned nloc = b.st[0], nx = b.st[1];
        if (nloc == 0u) { xcd_barrier_complete(bar, b.x, nloc, nx); b.st[0] = nloc; b.st[1] = nx; }
        const unsigned old = xb_add(&bar[XB_XSUB(b.x)], 1u);
        const unsigned gen = old / nloc;
        if (old + 1u == (gen + 1u) * nloc) {
            __builtin_amdgcn_fence(__ATOMIC_RELEASE, "agent");
            asm volatile("s_waitcnt vmcnt(0)" ::: "memory");
            const unsigned og = xb_add(&bar[XB_TOP], 1u);
            const unsigned tg = og / nx;
            if (og + 1u == (tg + 1u) * nx) xb_add(&bar[XB_TOPGEN], 1u);
            else XB_SPIN(xb_ld(&bar[XB_TOPGEN]) == tg, bar);
            __builtin_amdgcn_fence(__ATOMIC_ACQUIRE, "agent");
            xb_add(&bar[XB_XGEN(b.x)], 1u);
            asm volatile("s_waitcnt vmcnt(0)" ::: "memory");
        } else {
            XB_SPIN(xb_ld(&bar[XB_XGEN(b.x)]) == gen, bar);
            __builtin_amdgcn_fence(__ATOMIC_ACQUIRE, "agent");
            asm volatile("s_waitcnt vmcnt(0)" ::: "memory");
        }
    }
    __syncthreads();
}

namespace pg8 {
constexpr int BM = 256, BK = 64, HALF = 128, HTB = HALF * BK * 2, STAGE_BYTES = 8 * HTB, NXCD = 8, WGM = 8;
__host__ __device__ __forceinline__ int lds_byte(int r, int c) { const int st = (r >> 4) * 2 + (c >> 5), rr = r & 15, cc = c & 31, ob = rr * 64 + cc * 2; return st * 1024 + (ob ^ (((ob >> 9) & 1) << 5)); }
__host__ __device__ __forceinline__ void stage_rc(int b, int& R, int& C) { const int st = b / 1024, sb = b % 1024, swz = sb ^ (((sb >> 9) & 1) << 5); R = (st >> 1) * 16 + swz / 64; C = (st & 1) * 32 + (swz % 64) / 2; }
__host__ __device__ __forceinline__ int perm32(int rho) { const int n = rho >> 4, i = rho & 15; return 8 * (i >> 2) + 4 * n + (i & 3); }

__device__ __forceinline__ i32x8 cat8(bf16x8 a, bf16x8 b) { const i32x4 x = __builtin_bit_cast(i32x4, a), y = __builtin_bit_cast(i32x4, b); return __builtin_shufflevector(x, y, 0, 1, 2, 3, 4, 5, 6, 7); }
__device__ __forceinline__ void mfma8(f32x4& c, i32x8 a, i32x8 b) { asm volatile("v_mfma_f32_16x16x128_f8f6f4 %0, %1, %2, %0" : "+v"(c) : "v"(a), "v"(b)); }
#define MFMA_DRAIN() asm volatile("s_nop 15\n\ts_nop 15" ::: "memory")
struct Unit { int pm, pn; };
struct Gemm { const bf16_t* A; const bf16_t* Bt; int M, N, K; };

struct StaticOrder {
    int nM, nN, nwg, G, c;
    __device__ void init(int M, int N, int G_, int c_) { nM = M / BM; nN = N / BM; nwg = nM * nN; G = G_; c = c_; }
    __device__ bool next(int i, Unit& u) const {
        const long L = (long)i * G + c; if (L >= nwg) return false;
        int wgid = (int)L; { const int q = nwg / NXCD, r = nwg % NXCD, xcd = wgid % NXCD, off = wgid / NXCD; wgid = (xcd < r ? xcd * (q + 1) : r * (q + 1) + (xcd - r) * q) + off; }
        const int nig = WGM * nN, gid = wgid / nig, fm = gid * WGM, gsz = (nM - fm) < WGM ? (nM - fm) : WGM;
        u.pm = fm + ((wgid % nig) % gsz); u.pn = (wgid % nig) / gsz; return true;
    }
    __device__ __forceinline__ void a_ready(const Unit&) const {}
    __device__ __forceinline__ void done(const Unit&) const {}
};
struct SubsetOrder {
    StaticOrder so; int l0, b0, l1, b1, b2;
    __device__ bool next(int i, Unit& u) const { if (!so.next(i, u)) return false; const int j = u.pn; u.pn = j < l0 ? b0 + j : j < l0 + l1 ? b1 + (j - l0) : b2 + (j - l0 - l1); return true; }
    __device__ __forceinline__ void a_ready(const Unit&) const {}
    __device__ __forceinline__ void done(const Unit&) const {}
};
struct P7Order {
    int G, c, nq, nextra;
    __device__ bool next(int i, Unit& u) const {
        const int L = i * G + c;
        if (L < nq) { if (i == 0 && (nq & 15) == 0 && nq <= G && (G & 7) == 0 && ((G - nq) & 7) == 0) { const int x = c & 7, j = c >> 3, ppx = nq >> 4; u.pm = x * ppx + (j >> 1); u.pn = j & 1; }
                      else { u.pm = L >> 1; u.pn = L & 1; } return true; }
        const int j = L - nq; if (j >= nextra) return false;
        u.pm = 64 + (j & 1); u.pn = 2 + (j >> 1); return true;
    }
    __device__ __forceinline__ void a_ready(const Unit&) const {}
    __device__ __forceinline__ void done(const Unit&) const {}
};
struct GroupedOrder {
    int G, c, nct; const int* panel_e; int p0, npanels;
    __device__ bool next(int i, Unit& u) const {
        const int L = (G & 7) == 0 ? i * G + (c & 7) * (G >> 3) + (c >> 3) : i * G + c; if (L >= npanels * nct) return false;
        const int p = p0 + L / nct, ct = L % nct; u.pm = p; u.pn = __builtin_amdgcn_readfirstlane(panel_e[p]) * nct + ct; return true;
    }
    __device__ __forceinline__ void a_ready(const Unit&) const {}
    __device__ __forceinline__ void done(const Unit&) const {}
};
struct OneUnitOrder {
    int c, nct; const int* panel_e; int p0, nunits;
    __device__ bool next(int i, Unit& u) const {
        if (i != 0 || c >= nunits) return false;
        const int p = p0 + c / nct, ct = c % nct; u.pm = p; u.pn = __builtin_amdgcn_readfirstlane(panel_e[p]) * nct + ct; return true;
    }
    __device__ __forceinline__ void a_ready(const Unit&) const {}
    __device__ __forceinline__ void done(const Unit&) const {}
};
struct GroupedSkewOrder {
    int G, c, nct; const int* panel_e; int npanels, nlong, skip;
    __device__ bool next(int i, Unit& u) const {
        const int S = G - nlong; int L;
        if ((G & 7) == 0 && (nlong & 7) == 0) {
            const int x = c & 7, j = c >> 3, jl = (c - nlong) >> 3;
            if (c >= nlong) L = (i < skip) ? i * S + x * (S >> 3) + jl : skip * S + (i - skip) * G + x * (G >> 3) + j; else L = skip * S + i * G + x * (G >> 3) + j;
        } else if (c >= nlong) L = (i < skip) ? i * S + (c - nlong) : skip * S + (i - skip) * G + c; else L = skip * S + i * G + c;
        if (L >= npanels * nct) return false;
        const int p = L / nct, ct = L % nct; u.pm = p; u.pn = __builtin_amdgcn_readfirstlane(panel_e[p]) * nct + ct; return true;
    }
    __device__ __forceinline__ void a_ready(const Unit&) const {}
    __device__ __forceinline__ void done(const Unit&) const {}
};

struct EpiScaleBf16 {
    static constexpr bool PERM = true, AFTER_DRAIN = false;
    bf16_t* O; int ldc; const float* rs; float* kpart; float dq;
    __device__ __forceinline__ void operator()(const f32x4 (&acc)[2][2][4][2], const Unit& u, int wr, int wc, int fr, int fq) const {
        const int row0 = u.pm * BM + wr * 64 + fr, col0 = u.pn * BM + wc * 32 + 8 * fq;
        const bool ksum = kpart != nullptr && u.pn >= 4 && u.pn < 8;
        f32x4 cs[2][2];
#pragma unroll
        for (int bj = 0; bj < 2; ++bj) { cs[bj][0] = (f32x4){0.f, 0.f, 0.f, 0.f}; cs[bj][1] = (f32x4){0.f, 0.f, 0.f, 0.f}; }
#pragma unroll
        for (int ai = 0; ai < 2; ++ai)
#pragma unroll
            for (int m = 0; m < 4; ++m) { const int row = row0 + ai * HALF + m * 16; const float s = rs[row] * dq; bf16_t* rowp = O + (size_t)row * ldc + col0;
#pragma unroll
                for (int bj = 0; bj < 2; ++bj) { const f32x4 v0 = acc[ai][bj][m][0] * s, v1 = acc[ai][bj][m][1] * s;
                    cs[bj][0] += v0; cs[bj][1] += v1;
                    u32x4 w; w.x = pk2(v0[0], v0[1]); w.y = pk2(v0[2], v0[3]); w.z = pk2(v1[0], v1[1]); w.w = pk2(v1[2], v1[3]);
                    *(u32x4*)(rowp + bj * HALF) = w; } }
        if (ksum) {
#pragma unroll
            for (int bj = 0; bj < 2; ++bj)
#pragma unroll
                for (int n = 0; n < 2; ++n)
#pragma unroll
                    for (int j = 0; j < 4; ++j) { float v = cs[bj][n][j]; v += __shfl_xor(v, 1); v += __shfl_xor(v, 2); v += __shfl_xor(v, 4); v += __shfl_xor(v, 8); cs[bj][n][j] = v; }
            if (fr == 0) { float* kp = kpart + (size_t)(wr * 64 + u.pm) * 1024 + (col0 - 1024);
#pragma unroll
                for (int bj = 0; bj < 2; ++bj) { *(f32x4*)(kp + bj * HALF) = cs[bj][0]; *(f32x4*)(kp + bj * HALF + 4) = cs[bj][1]; } }
        }
    }
};
struct EpiP7 {
    static constexpr bool PERM = true, AFTER_DRAIN = false;
    bf16_t* qc; bf16_t* kvc; const float* rs_all;
    __device__ __forceinline__ void operator()(const f32x4 (&acc)[2][2][4][2], const Unit& u, int wr, int wc, int fr, int fq) const {
        const bool isq = u.pm < 64;
        const int lrow0 = wr * 64 + fr, cofs = wc * 32 + 8 * fq;
        const int j = u.pn - 2;
#pragma unroll
        for (int ai = 0; ai < 2; ++ai)
#pragma unroll
            for (int m = 0; m < 4; ++m) { const int lrow = lrow0 + ai * HALF + m * 16;
                float s = 1.0f; bf16_t* rowp;
                if (isq) { rowp = qc + (size_t)(u.pm * BM + lrow) * 512 + u.pn * BM + cofs; }
                else { const int r = (u.pm - 64) * BM + lrow; s = rs_all[T + r]; rowp = kvc + (size_t)(j >> 2) * 512 * 1024 + (size_t)r * 1024 + (j & 3) * BM + cofs; }
#pragma unroll
                for (int bj = 0; bj < 2; ++bj) { const f32x4 v0 = acc[ai][bj][m][0] * s, v1 = acc[ai][bj][m][1] * s;
                    u32x4 w; w.x = pk2(v0[0], v0[1]); w.y = pk2(v0[2], v0[3]); w.z = pk2(v1[0], v1[1]); w.w = pk2(v1[2], v1[3]);
                    *(u32x4*)(rowp + bj * HALF) = w; } }
    }
};
struct EpiRes {
    static constexpr bool PERM = true, AFTER_DRAIN = false;
    bf16_t* xb; float* ssqp; unsigned char* x8;
    __device__ __forceinline__ void operator()(const f32x4 (&acc)[2][2][4][2], const Unit& u, int wr, int wc, int fr, int fq) const {
        const int row0 = u.pm * BM + wr * 64 + fr, col0 = u.pn * BM + wc * 32 + 8 * fq;
#pragma unroll
        for (int ai = 0; ai < 2; ++ai) {
            u32x4 xo[4][2];
#pragma unroll
            for (int m = 0; m < 4; ++m)
#pragma unroll
                for (int bj = 0; bj < 2; ++bj) xo[m][bj] = *(const u32x4*)(xb + (size_t)(row0 + ai * HALF + m * 16) * D + col0 + bj * HALF);
            asm volatile("" ::: "memory");
#pragma unroll
            for (int m = 0; m < 4; ++m) { const int row = row0 + ai * HALF + m * 16; float ss = 0.f;
#pragma unroll
                for (int bj = 0; bj < 2; ++bj) { const u32x4 xv = xo[m][bj];
                    const f32x4 v0 = acc[ai][bj][m][0] + (f32x4){bf_lo(xv.x), bf_hi(xv.x), bf_lo(xv.y), bf_hi(xv.y)};
                    const f32x4 v1 = acc[ai][bj][m][1] + (f32x4){bf_lo(xv.z), bf_hi(xv.z), bf_lo(xv.w), bf_hi(xv.w)};
                    ss += ((v0[0] * v0[0] + v0[1] * v0[1]) + (v0[2] * v0[2] + v0[3] * v0[3])) + ((v1[0] * v1[0] + v1[1] * v1[1]) + (v1[2] * v1[2] + v1[3] * v1[3]));
                    u32x4 w; w.x = pk2(v0[0], v0[1]); w.y = pk2(v0[2], v0[3]); w.z = pk2(v1[0], v1[1]); w.w = pk2(v1[2], v1[3]);
                    *(u32x4*)(xb + (size_t)row * D + col0 + bj * HALF) = w;
                    if (x8) { u32x2 q; q.x = pk4f8(v0 * X8_SCALE); q.y = pk4f8(v1 * X8_SCALE); *(u32x2*)(x8 + (size_t)row * D + col0 + bj * HALF) = q; } }
                ss += __shfl_xor(ss, 16); ss += __shfl_xor(ss, 32);
                if (fq == 0) ssqp[(size_t)row * 32 + u.pn * 4 + wc] = ss; }
            asm volatile("" ::: "memory");
        }
    }
};
struct EpiMoe1 {
    static constexpr bool PERM = true, AFTER_DRAIN = false;
    unsigned char* H; const f32x4* rowinfo; float dq;
    __device__ __forceinline__ void operator()(const f32x4 (&acc)[2][2][4][2], const Unit& u, int wr, int wc, int fr, int fq) const {
        const int row0 = u.pm * BM + wr * 64 + fr, col0 = (u.pn & 3) * HALF + wc * 32 + 8 * fq;
#pragma unroll
        for (int ai = 0; ai < 2; ++ai)
#pragma unroll
            for (int m = 0; m < 4; ++m) { const int row = row0 + ai * HALF + m * 16; const f32x4 info = rowinfo[row]; const float rs = info[2] * dq, ew = info[1] * H8_SCALE;
                float h[8];
#pragma unroll
                for (int n = 0; n < 2; ++n)
#pragma unroll
                    for (int q = 0; q < 4; ++q) { const float a = acc[ai][0][m][n][q] * rs, c = acc[ai][1][m][n][q] * rs;
                        const float sg = __builtin_amdgcn_rcpf(1.0f + __expf(-a)); h[n * 4 + q] = a * sg * c * ew; }
                u32x2 w; w.x = pk4f8((f32x4){h[0], h[1], h[2], h[3]}); w.y = pk4f8((f32x4){h[4], h[5], h[6], h[7]});
                *(u32x2*)(H + (size_t)row * 512 + col0) = w; }
    }
};
struct EpiMoe2 {
    static constexpr bool PERM = true, AFTER_DRAIN = false;
    bf16_t* Y; float dq;
    __device__ __forceinline__ void operator()(const f32x4 (&acc)[2][2][4][2], const Unit& u, int wr, int wc, int fr, int fq) const {
        const int row0 = u.pm * BM + wr * 64 + fr, col0 = (u.pn & 7) * BM + wc * 32 + 8 * fq;
#pragma unroll
        for (int ai = 0; ai < 2; ++ai)
#pragma unroll
            for (int m = 0; m < 4; ++m) { bf16_t* rowp = Y + (size_t)(row0 + ai * HALF + m * 16) * D + col0;
#pragma unroll
                for (int bj = 0; bj < 2; ++bj) { const f32x4 v0 = acc[ai][bj][m][0] * dq, v1 = acc[ai][bj][m][1] * dq;
                    u32x4 w; w.x = pk2(v0[0], v0[1]); w.y = pk2(v0[2], v0[3]); w.z = pk2(v1[0], v1[1]); w.w = pk2(v1[2], v1[3]);
                    *(u32x4*)(rowp + bj * HALF) = w; } }
    }
};

template <class Epi, class Sched, bool F8 = false>
__device__ __forceinline__ void gemm_phase(LAS unsigned char* lds, const Gemm g, const Sched& S, const Epi& E) {
    int tid = threadIdx.x; asm volatile("" : "+v"(tid));
    const int wid = __builtin_amdgcn_readfirstlane(tid >> 6), lane = tid & 63, wr = wid >> 2, wc = wid & 3, fr = lane & 15, fq = lane >> 4;
    const int K = g.K, nt = K / BK;
    unsigned voffA[2], voffB[2];
#pragma unroll
    for (int i = 0; i < 2; ++i) { int R, C; stage_rc(tid * 16 + i * 8192, R, C); const int Rb = Epi::PERM ? ((R & ~31) + perm32(R & 31)) : R;
        voffA[i] = (unsigned)(R * K + C) * 2u; voffB[i] = (unsigned)(Rb * K + C) * 2u; }
    const size_t kstep = (size_t)(BK * 2);
    const size_t hstep = (size_t)HALF * K * 2;
    const size_t tstep = 2 * hstep;
    const unsigned ldsw = (unsigned)wid * 1024u;
    const int aoff = lds_byte(wr * 64 + fr, fq * 8), boff = lds_byte(wc * 32 + fr, fq * 8);
#define PG8_SA(b, h) (((b) * 2 + (h)) * HTB)
#define PG8_SB(b, h) ((4 + (b) * 2 + (h)) * HTB)
#define PG8_STAGE(bufoff, gbase, voff) do { _Pragma("unroll") for (int _i = 0; _i < 2; ++_i) \
        __builtin_amdgcn_global_load_lds((const unsigned*)((const char*)(gbase) + (voff)[_i]), (LAS unsigned*)(lds + (bufoff) + ldsw + _i * 8192), 16, 0, 0); } while (0)
#define PG8_LDA(dst, b, h) do { _Pragma("unroll") for (int m = 0; m < 4; ++m) _Pragma("unroll") for (int k = 0; k < 2; ++k) dst[m][k] = *(const LAS bf16x8*)(lds + PG8_SA(b, h) + aoff + m * 2048 + k * 1024); } while (0)
#define PG8_LDB(dst, b, h) do { _Pragma("unroll") for (int n = 0; n < 2; ++n) _Pragma("unroll") for (int k = 0; k < 2; ++k) dst[n][k] = *(const LAS bf16x8*)(lds + PG8_SB(b, h) + boff + n * 2048 + k * 1024); } while (0)
#define PG8_MMA(ai, bj, At, Bt) do { __builtin_amdgcn_s_setprio(1); _Pragma("unroll") for (int m = 0; m < 4; ++m) _Pragma("unroll") for (int n = 0; n < 2; ++n) { \
        if constexpr (F8) mfma8(acc[ai][bj][m][n], cat8(Bt[n][0], Bt[n][1]), cat8(At[m][0], At[m][1])); \
        else { _Pragma("unroll") for (int k = 0; k < 2; ++k) acc[ai][bj][m][n] = __builtin_amdgcn_mfma_f32_16x16x32_bf16(Bt[n][k], At[m][k], acc[ai][bj][m][n], 0, 0, 0); } } __builtin_amdgcn_s_setprio(0); } while (0)
#define PG8_WAIT_V(n) asm volatile("s_waitcnt vmcnt(" #n ")" ::: "memory")
#define PG8_WAIT_L(n) asm volatile("s_waitcnt lgkmcnt(" #n ")" ::: "memory")
#define PG8_BAR __builtin_amdgcn_s_barrier()
#define PG8_SCHED __builtin_amdgcn_sched_barrier(0)
    Unit cur, nxt; int ui = 0;
    if (!S.next(0, cur)) return;
    f32x4 acc[2][2][4][2];
#pragma unroll
    for (int a = 0; a < 2; ++a)
#pragma unroll
        for (int b = 0; b < 2; ++b)
#pragma unroll
            for (int m = 0; m < 4; ++m)
#pragma unroll
                for (int n = 0; n < 2; ++n) acc[a][b][m][n] = (f32x4){0.f, 0.f, 0.f, 0.f};
    bf16x8 At[4][2], B0[2][2], B1[2][2];
    const char* cA = (const char*)g.A + (size_t)cur.pm * tstep; const char* cB = (const char*)g.Bt + (size_t)cur.pn * tstep;
    S.a_ready(cur);
    PG8_STAGE(PG8_SB(0, 0), cB, voffB); PG8_STAGE(PG8_SA(0, 0), cA, voffA); PG8_STAGE(PG8_SB(0, 1), cB + hstep, voffB); PG8_STAGE(PG8_SA(0, 1), cA + hstep, voffA);
    if (wr == 1) PG8_BAR;
    PG8_WAIT_V(4); PG8_BAR;
    PG8_STAGE(PG8_SB(1, 0), cB + kstep, voffB); PG8_STAGE(PG8_SA(1, 0), cA + kstep, voffA); PG8_STAGE(PG8_SB(1, 1), cB + hstep + kstep, voffB);
    PG8_WAIT_V(6); PG8_BAR;
    for (;;) {
        const bool has_next = S.next(ui + 1, nxt);
        const char* nA = has_next ? (const char*)g.A + (size_t)nxt.pm * tstep : cA; const char* nB = has_next ? (const char*)g.Bt + (size_t)nxt.pn * tstep : cB;
        for (int t = 0; t < nt; t += 2) {
            const bool last = (t == nt - 2);
            const char* a1 = cA + (size_t)(t + 1) * kstep;
            const char* a2 = last ? nA : cA + (size_t)(t + 2) * kstep; const char* b2 = last ? nB : cB + (size_t)(t + 2) * kstep;
            const char* a3 = a2 + kstep; const char* b3 = b2 + kstep;
            if (last && has_next) S.a_ready(nxt);
            PG8_LDB(B0, 0, 0); PG8_SCHED; PG8_LDA(At, 0, 0); PG8_STAGE(PG8_SA(1, 1), a1 + hstep, voffA);
            PG8_WAIT_L(8); PG8_BAR; PG8_WAIT_L(0); PG8_MMA(0, 0, At, B0); PG8_BAR; PG8_SCHED;
            PG8_LDB(B1, 0, 1); PG8_STAGE(PG8_SB(0, 0), b2, voffB);
            PG8_BAR; PG8_WAIT_L(0); PG8_MMA(0, 1, At, B1); PG8_BAR;
            PG8_LDA(At, 0, 1); PG8_STAGE(PG8_SA(0, 0), a2, voffA);
            PG8_BAR; PG8_WAIT_L(0); PG8_MMA(1, 0, At, B0); PG8_BAR; PG8_SCHED;
            PG8_STAGE(PG8_SB(0, 1), b2 + hstep, voffB);
            PG8_WAIT_V(6); PG8_BAR; PG8_MMA(1, 1, At, B1); PG8_BAR;
            PG8_LDB(B0, 1, 0); PG8_SCHED; PG8_LDA(At, 1, 0); PG8_STAGE(PG8_SA(0, 1), a2 + hstep, voffA);
            PG8_WAIT_L(8); PG8_BAR; PG8_WAIT_L(0); PG8_MMA(0, 0, At, B0); PG8_BAR; PG8_SCHED;
            PG8_LDB(B1, 1, 1); PG8_STAGE(PG8_SB(1, 0), b3, voffB);
            PG8_BAR; PG8_WAIT_L(0); PG8_MMA(0, 1, At, B1); PG8_BAR;
            PG8_LDA(At, 1, 1); PG8_STAGE(PG8_SA(1, 0), a3, voffA);
            PG8_BAR; PG8_WAIT_L(0); PG8_MMA(1, 0, At, B0); PG8_BAR; PG8_SCHED;
            PG8_STAGE(PG8_SB(1, 1), b3 + hstep, voffB);
            PG8_WAIT_V(6); PG8_BAR; PG8_MMA(1, 1, At, B1); PG8_BAR;
        }
        if constexpr (F8) MFMA_DRAIN();
        E(acc, cur, wr, wc, fr, fq); S.done(cur);
        if (!has_next) break;
#pragma unroll
        for (int a = 0; a < 2; ++a)
#pragma unroll
            for (int b = 0; b < 2; ++b)
#pragma unroll
                for (int m = 0; m < 4; ++m)
#pragma unroll
                    for (int n = 0; n < 2; ++n) acc[a][b][m][n] = (f32x4){0.f, 0.f, 0.f, 0.f};
        cur = nxt; cA = nA; cB = nB; ++ui;
    }
    PG8_WAIT_V(0);
    if (wr == 0) PG8_BAR;
    PG8_BAR;
#undef PG8_SA
#undef PG8_SB
#undef PG8_STAGE
#undef PG8_LDA
#undef PG8_LDB
#undef PG8_MMA
#undef PG8_WAIT_V
#undef PG8_WAIT_L
#undef PG8_BAR
#undef PG8_SCHED
}
template <class Epi, class Sched, bool F8 = false>
__device__ __forceinline__ void gemm_phase_gather(LAS unsigned char* lds, const Gemm g, const Sched& S, const Epi& E, const int* rowtok) {
    int tid = threadIdx.x; asm volatile("" : "+v"(tid));
    const int wid = __builtin_amdgcn_readfirstlane(tid >> 6), lane = tid & 63, wr = wid >> 2, wc = wid & 3, fr = lane & 15, fq = lane >> 4;
    const int K = g.K, nt = K / BK;
    unsigned voffB[2]; int rA[2]; unsigned cA2[2];
#pragma unroll
    for (int i = 0; i < 2; ++i) { int R, C; stage_rc(tid * 16 + i * 8192, R, C); const int Rb = Epi::PERM ? ((R & ~31) + perm32(R & 31)) : R;
        rA[i] = R; cA2[i] = (unsigned)C * 2u; voffB[i] = (unsigned)(Rb * K + C) * 2u; }
    const unsigned rowb = (unsigned)K * 2u;
    unsigned ofsC[2][2], ofsN[2][2];
#define PG8_LOADOFS(dst, pm_) do { _Pragma("unroll") for (int h_ = 0; h_ < 2; ++h_) _Pragma("unroll") for (int i_ = 0; i_ < 2; ++i_) \
        dst[h_][i_] = (unsigned)rowtok[(pm_) * BM + h_ * HALF + rA[i_]] * rowb + cA2[i_]; asm volatile("" : "+v"(dst[0][0]), "+v"(dst[0][1]), "+v"(dst[1][0]), "+v"(dst[1][1])); } while (0)
#define PG8_STAGE_A(bufoff, kbyte, o0, o1) do { \
        __builtin_amdgcn_global_load_lds((const unsigned*)((const char*)g.A + (kbyte) + (o0)), (LAS unsigned*)(lds + (bufoff) + ldsw), 16, 0, 0); \
        __builtin_amdgcn_global_load_lds((const unsigned*)((const char*)g.A + (kbyte) + (o1)), (LAS unsigned*)(lds + (bufoff) + ldsw + 8192), 16, 0, 0); } while (0)
    const size_t kstep = (size_t)(BK * 2);
    const size_t hstep = (size_t)HALF * K * 2;
    const size_t tstep = 2 * hstep;
    const unsigned ldsw = (unsigned)wid * 1024u;
    const int aoff = lds_byte(wr * 64 + fr, fq * 8), boff = lds_byte(wc * 32 + fr, fq * 8);
#define PG8_SA(b, h) (((b) * 2 + (h)) * HTB)
#define PG8_SB(b, h) ((4 + (b) * 2 + (h)) * HTB)
#define PG8_STAGE(bufoff, gbase, voff) do { _Pragma("unroll") for (int _i = 0; _i < 2; ++_i) \
        __builtin_amdgcn_global_load_lds((const unsigned*)((const char*)(gbase) + (voff)[_i]), (LAS unsigned*)(lds + (bufoff) + ldsw + _i * 8192), 16, 0, 0); } while (0)
#define PG8_LDA(dst, b, h) do { _Pragma("unroll") for (int m = 0; m < 4; ++m) _Pragma("unroll") for (int k = 0; k < 2; ++k) dst[m][k] = *(const LAS bf16x8*)(lds + PG8_SA(b, h) + aoff + m * 2048 + k * 1024); } while (0)
#define PG8_LDB(dst, b, h) do { _Pragma("unroll") for (int n = 0; n < 2; ++n) _Pragma("unroll") for (int k = 0; k < 2; ++k) dst[n][k] = *(const LAS bf16x8*)(lds + PG8_SB(b, h) + boff + n * 2048 + k * 1024); } while (0)
#define PG8_MMA(ai, bj, At, Bt) do { __builtin_amdgcn_s_setprio(1); _Pragma("unroll") for (int m = 0; m < 4; ++m) _Pragma("unroll") for (int n = 0; n < 2; ++n) { \
        if constexpr (F8) mfma8(acc[ai][bj][m][n], cat8(Bt[n][0], Bt[n][1]), cat8(At[m][0], At[m][1])); \
        else { _Pragma("unroll") for (int k = 0; k < 2; ++k) acc[ai][bj][m][n] = __builtin_amdgcn_mfma_f32_16x16x32_bf16(Bt[n][k], At[m][k], acc[ai][bj][m][n], 0, 0, 0); } } __builtin_amdgcn_s_setprio(0); } while (0)
#define PG8_WAIT_V(n) asm volatile("s_waitcnt vmcnt(" #n ")" ::: "memory")
#define PG8_WAIT_L(n) asm volatile("s_waitcnt lgkmcnt(" #n ")" ::: "memory")
#define PG8_BAR __builtin_amdgcn_s_barrier()
#define PG8_SCHED __builtin_amdgcn_sched_barrier(0)
    Unit cur, nxt; int ui = 0;
    if (!S.next(0, cur)) return;
    f32x4 acc[2][2][4][2];
#pragma unroll
    for (int a = 0; a < 2; ++a)
#pragma unroll
        for (int b = 0; b < 2; ++b)
#pragma unroll
            for (int m = 0; m < 4; ++m)
#pragma unroll
                for (int n = 0; n < 2; ++n) acc[a][b][m][n] = (f32x4){0.f, 0.f, 0.f, 0.f};
    bf16x8 At[4][2], B0[2][2], B1[2][2];
    const char* cB = (const char*)g.Bt + (size_t)cur.pn * tstep;
    PG8_LOADOFS(ofsC, cur.pm);
    PG8_STAGE(PG8_SB(0, 0), cB, voffB); PG8_STAGE_A(PG8_SA(0, 0), 0, ofsC[0][0], ofsC[0][1]); PG8_STAGE(PG8_SB(0, 1), cB + hstep, voffB); PG8_STAGE_A(PG8_SA(0, 1), 0, ofsC[1][0], ofsC[1][1]);
    if (wr == 1) PG8_BAR;
    PG8_WAIT_V(4); PG8_BAR;
    PG8_STAGE(PG8_SB(1, 0), cB + kstep, voffB); PG8_STAGE_A(PG8_SA(1, 0), kstep, ofsC[0][0], ofsC[0][1]); PG8_STAGE(PG8_SB(1, 1), cB + hstep + kstep, voffB);
    PG8_WAIT_V(6); PG8_BAR;
    for (;;) {
        const bool has_next = S.next(ui + 1, nxt);
        const char* nB = has_next ? (const char*)g.Bt + (size_t)nxt.pn * tstep : cB;
        if (has_next) PG8_LOADOFS(ofsN, nxt.pm); else { ofsN[0][0] = ofsC[0][0]; ofsN[0][1] = ofsC[0][1]; ofsN[1][0] = ofsC[1][0]; ofsN[1][1] = ofsC[1][1]; }
        for (int t = 0; t < nt; t += 2) {
            const bool last = (t == nt - 2);
            const size_t k1 = (size_t)(t + 1) * kstep, k2 = last ? 0 : (size_t)(t + 2) * kstep, k3 = k2 + kstep;
            const char* b2 = last ? nB : cB + (size_t)(t + 2) * kstep; const char* b3 = b2 + kstep;
            const unsigned o00 = last ? ofsN[0][0] : ofsC[0][0], o01 = last ? ofsN[0][1] : ofsC[0][1], o10 = last ? ofsN[1][0] : ofsC[1][0], o11 = last ? ofsN[1][1] : ofsC[1][1];
            PG8_LDB(B0, 0, 0); PG8_SCHED; PG8_LDA(At, 0, 0); PG8_STAGE_A(PG8_SA(1, 1), k1, ofsC[1][0], ofsC[1][1]);
            PG8_WAIT_L(8); PG8_BAR; PG8_WAIT_L(0); PG8_MMA(0, 0, At, B0); PG8_BAR; PG8_SCHED;
            PG8_LDB(B1, 0, 1); PG8_STAGE(PG8_SB(0, 0), b2, voffB);
            PG8_BAR; PG8_WAIT_L(0); PG8_MMA(0, 1, At, B1); PG8_BAR;
            PG8_LDA(At, 0, 1); PG8_STAGE_A(PG8_SA(0, 0), k2, o00, o01);
            PG8_BAR; PG8_WAIT_L(0); PG8_MMA(1, 0, At, B0); PG8_BAR; PG8_SCHED;
            PG8_STAGE(PG8_SB(0, 1), b2 + hstep, voffB);
            PG8_WAIT_V(6); PG8_BAR; PG8_MMA(1, 1, At, B1); PG8_BAR;
            PG8_LDB(B0, 1, 0); PG8_SCHED; PG8_LDA(At, 1, 0); PG8_STAGE_A(PG8_SA(0, 1), k2, o10, o11);
            PG8_WAIT_L(8); PG8_BAR; PG8_WAIT_L(0); PG8_MMA(0, 0, At, B0); PG8_BAR; PG8_SCHED;
            PG8_LDB(B1, 1, 1); PG8_STAGE(PG8_SB(1, 0), b3, voffB);
            PG8_BAR; PG8_WAIT_L(0); PG8_MMA(0, 1, At, B1); PG8_BAR;
            PG8_LDA(At, 1, 1); PG8_STAGE_A(PG8_SA(1, 0), k3, o00, o01);
            PG8_BAR; PG8_WAIT_L(0); PG8_MMA(1, 0, At, B0); PG8_BAR; PG8_SCHED;
            PG8_STAGE(PG8_SB(1, 1), b3 + hstep, voffB);
            PG8_WAIT_V(6); PG8_BAR; PG8_MMA(1, 1, At, B1); PG8_BAR;
        }
        if constexpr (F8) MFMA_DRAIN();
        E(acc, cur, wr, wc, fr, fq); S.done(cur);
        if (!has_next) break;
#pragma unroll
        for (int a = 0; a < 2; ++a)
#pragma unroll
            for (int b = 0; b < 2; ++b)
#pragma unroll
                for (int m = 0; m < 4; ++m)
#pragma unroll
                    for (int n = 0; n < 2; ++n) acc[a][b][m][n] = (f32x4){0.f, 0.f, 0.f, 0.f};
        cur = nxt; cB = nB; ++ui; ofsC[0][0] = ofsN[0][0]; ofsC[0][1] = ofsN[0][1]; ofsC[1][0] = ofsN[1][0]; ofsC[1][1] = ofsN[1][1];
    }
    PG8_WAIT_V(0);
    if (wr == 0) PG8_BAR;
    PG8_BAR;
#undef PG8_SA
#undef PG8_LOADOFS
#undef PG8_STAGE_A
#undef PG8_SB
#undef PG8_STAGE
#undef PG8_LDA
#undef PG8_LDB
#undef PG8_MMA
#undef PG8_WAIT_V
#undef PG8_WAIT_L
#undef PG8_BAR
#undef PG8_SCHED
}
}

enum InIdx { I_X = 0, I_MEM, I_GMIX, I_WIN, I_WOUT, I_POOLW, I_POOLS, I_GMEM, I_GMEMKV, I_WMQ, I_WMK, I_WMV, I_WMO, I_GFFN, I_WGROUP, I_BGROUP, I_WROUTER, I_BROUTER, I_W1, I_W3, I_W2, I_GFINAL, N_IN };
struct Args { const float* in[N_IN]; float* out; unsigned char* ws; int ph_lo, ph_hi, li, pad; };

typedef const __attribute__((address_space(4))) Args* CArgsP;
__device__ __forceinline__ CArgsP kargs() { CArgsP p = (CArgsP)__builtin_amdgcn_kernarg_segment_ptr(); asm volatile("" : "+s"(p)); return p; }

struct Frame {
    LAS unsigned char* lds;
    int tid, lane, wave, gw, NGW, G;
};
__device__ __forceinline__ Frame make_frame(LAS unsigned char* lds) {
    Frame F; int tz = threadIdx.x; asm volatile("" : "+v"(tz));
    F.lds = lds; F.tid = tz; F.lane = tz & 63; F.wave = __builtin_amdgcn_readfirstlane(tz >> 6);
    F.G = gridDim.x; F.gw = blockIdx.x * 8 + F.wave; F.NGW = F.G * 8;
    return F;
}

__device__ __forceinline__ void conv_item(const float* W, int K, int N, const float* gain, bf16_t* WT, int rowbase, int blkshift, int blkstride, LAS float* scr_, int item, int lane) {
    LAS unsigned char* scr = (LAS unsigned char*)scr_;
    const int nblk = N / 64, kb = item / nblk, nb = item % nblk, k0 = 64 * kb, n0 = 64 * nb;
    const int nq = lane & 15, kr = lane >> 4;
    f32x4 v[16];
#pragma unroll
    for (int i = 0; i < 16; ++i) v[i] = *(const f32x4*)(W + (size_t)(k0 + 16 * (i >> 2) + 4 * kr + (i & 3)) * N + n0 + 4 * nq);
    if (gain) {
#pragma unroll
        for (int kbk = 0; kbk < 4; ++kbk) { const f32x4 g4 = *(const f32x4*)(gain + k0 + 16 * kbk + 4 * kr);
#pragma unroll
            for (int c = 0; c < 4; ++c) v[4 * kbk + c] = v[4 * kbk + c] * g4[c]; }
    }
#pragma unroll
    for (int kbk = 0; kbk < 4; ++kbk)
#pragma unroll
        for (int j = 0; j < 4; ++j) { u32x2 w; w.x = pk2(v[4 * kbk][j], v[4 * kbk + 1][j]); w.y = pk2(v[4 * kbk + 2][j], v[4 * kbk + 3][j]);
            *(LAS u32x2*)(scr + (4 * nq + j) * 144 + kbk * 32 + 8 * kr) = w; }
    LDS_WAIT();
    const int c = lane & 7;
    const int drow0 = rowbase + (n0 >> blkshift) * blkstride + (n0 & ((1 << blkshift) - 1));
#pragma unroll
    for (int i = 0; i < 8; ++i) { const int n = (lane >> 3) + 8 * i; const u32x4 o = *(const LAS u32x4*)(scr + n * 144 + 16 * c);
        const int drow = drow0 + n;
        *(u32x4*)(WT + (size_t)drow * K + k0 + 8 * c) = o; }
    LDS_WAIT();
}

__device__ __forceinline__ void conv_item8(const float* W, int K, int N, const float* gain, float scale, unsigned char* WT, int rowbase, int blkshift, int blkstride, LAS float* scr_, int item, int lane) {
    LAS unsigned char* scr = (LAS unsigned char*)scr_;
    const int nblk = N / 64, kb = item / nblk, nb = item % nblk, k0 = 64 * kb, n0 = 64 * nb;
    const int nq = lane & 15, kr = lane >> 4;
    f32x4 v[16];
#pragma unroll
    for (int i = 0; i < 16; ++i) v[i] = *(const f32x4*)(W + (size_t)(k0 + 16 * (i >> 2) + 4 * kr + (i & 3)) * N + n0 + 4 * nq);
#pragma unroll
    for (int kbk = 0; kbk < 4; ++kbk) { const f32x4 g4 = gain ? *(const f32x4*)(gain + k0 + 16 * kbk + 4 * kr) * scale : (f32x4){scale, scale, scale, scale};
#pragma unroll
        for (int c = 0; c < 4; ++c) v[4 * kbk + c] = v[4 * kbk + c] * g4[c]; }
#pragma unroll
    for (int kbk = 0; kbk < 4; ++kbk)
#pragma unroll
        for (int j = 0; j < 4; ++j) *(LAS unsigned*)(scr + (4 * nq + j) * 80 + kbk * 16 + 4 * kr) = pk4f8((f32x4){v[4 * kbk][j], v[4 * kbk + 1][j], v[4 * kbk + 2][j], v[4 * kbk + 3][j]});
    LDS_WAIT();
    const int c = lane & 3;
    const int drow0 = rowbase + (n0 >> blkshift) * blkstride + (n0 & ((1 << blkshift) - 1));
#pragma unroll
    for (int i = 0; i < 4; ++i) { const int n = (lane >> 2) + 16 * i; const u32x4 o = *(const LAS u32x4*)(scr + n * 80 + 16 * c);
        *(u32x4*)(WT + (size_t)(drow0 + n) * K + k0 + 16 * c) = o; }
    LDS_WAIT();
}

__device__ __forceinline__ bool inproj_tile_bf16(int tile) { return tile == 12 || tile == 13 || tile >= 18; }
__device__ __forceinline__ void phase_prologue(LAS unsigned char* lds) {
    CArgsP ap = kargs(); Frame F = make_frame(lds);
    unsigned char* ws = ap->ws;
    LAS float* scr = (LAS float*)(F.lds + F.wave * 16384);
    bf16_t* win_t = (bf16_t*)(ws + WS_WIN); bf16_t* wout_t = (bf16_t*)(ws + WS_WOUT); bf16_t* wc_t = (bf16_t*)(ws + WS_WC); bf16_t* wmo_t = (bf16_t*)(ws + WS_WMO);
    constexpr int IT_IN = 32 * 80, IT_OUT = 24 * 32, IT_M = 32 * 8, IT_MO = 8 * 32;
    constexpr int IT_SMALL = IT_IN + IT_OUT + 3 * IT_M + IT_MO;
    for (int it = F.gw; it < 2 * IT_SMALL; it += F.NGW) {
        int r = it;
        const int l = r / IT_SMALL; r -= l * IT_SMALL;
        if (r < IT_IN) { const int tile = (r % 80) >> 2;
            if (inproj_tile_bf16(tile)) conv_item(ap->in[I_WIN] + (size_t)l * D * INC, D, INC, ap->in[I_GMIX] + l * D, win_t + (size_t)l * INC * D, 0, 30, 0, scr, r, F.lane);
            else conv_item8(ap->in[I_WIN] + (size_t)l * D * INC, D, INC, ap->in[I_GMIX] + l * D, W8_SCALE, ws + WS_WIN8 + (size_t)l * INC * D, 0, 30, 0, scr, r, F.lane);
            continue; } r -= IT_IN;
        if (r < IT_OUT) { conv_item(ap->in[I_WOUT] + (size_t)l * D * D, D, D, nullptr, wout_t + (size_t)l * D * D, 0, 30, 0, scr, r, F.lane); continue; } r -= IT_OUT;
        if (r < IT_M) { conv_item(ap->in[I_WMQ] + (size_t)l * D * 512, D, 512, ap->in[I_GMEM] + l * D, wc_t, l ? 2560 : 0, 30, 0, scr, r, F.lane); continue; } r -= IT_M;
        if (r < IT_M) { conv_item(ap->in[I_WMK] + (size_t)l * D * 512, D, 512, ap->in[I_GMEMKV] + l * D, wc_t, 512 + 1024 * l, 30, 0, scr, r, F.lane); continue; } r -= IT_M;
        if (r < IT_M) { conv_item(ap->in[I_WMV] + (size_t)l * D * 512, D, 512, ap->in[I_GMEMKV] + l * D, wc_t, 1024 + 1024 * l, 30, 0, scr, r, F.lane); continue; } r -= IT_M;
        conv_item(ap->in[I_WMO] + (size_t)l * 512 * D, 512, D, nullptr, wmo_t + (size_t)l * D * 512, 0, 30, 0, scr, r, F.lane);
    }
    __syncthreads();
    for (int it = blockIdx.x; it < 2 * 4 * 32; it += F.G) {
        const int l = it >> 7, g = (it >> 5) & 3, n0 = (it & 31) * 64;
        LAS float* Ap = (LAS float*)F.lds;
        LAS float* Bp = (LAS float*)(F.lds + 65536);
        const float* pw = ap->in[I_POOLW] + (size_t)(l * 4 + g) * 128 * 128; const float* psc = ap->in[I_POOLS] + l * 512 + g * 128;
        const float* wo = ap->in[I_WOUT] + (size_t)l * D * D + (size_t)(1536 + g * 128) * D + n0;
        for (int i = F.tid; i < 128 * 128; i += 512) Ap[i] = pw[i] * psc[i & 127];
        for (int i = F.tid; i < 128 * 64; i += 512) Bp[i] = wo[(size_t)(i >> 6) * D + (i & 63)];
        __syncthreads();
        const int nl = F.tid & 63, cg = F.tid >> 6;
        float acc[16];
#pragma unroll
        for (int cc = 0; cc < 16; ++cc) acc[cc] = 0.f;
        for (int d4 = 0; d4 < 32; ++d4) {
            const float w0 = Bp[(4 * d4 + 0) * 64 + nl], w1 = Bp[(4 * d4 + 1) * 64 + nl], w2 = Bp[(4 * d4 + 2) * 64 + nl], w3 = Bp[(4 * d4 + 3) * 64 + nl];
#pragma unroll
            for (int cc = 0; cc < 16; ++cc) { const f32x4 a4 = *(const LAS f32x4*)(Ap + (cg * 16 + cc) * 128 + 4 * d4); acc[cc] += a4[0] * w0 + a4[1] * w1 + a4[2] * w2 + a4[3] * w3; }
        }
        bf16_t* dst = wout_t + (size_t)l * D * D + (size_t)(n0 + nl) * D + 1536 + g * 128 + cg * 16;
        u32x4 o0, o1; o0.x = pk2(acc[0], acc[1]); o0.y = pk2(acc[2], acc[3]); o0.z = pk2(acc[4], acc[5]); o0.w = pk2(acc[6], acc[7]);
        o1.x = pk2(acc[8], acc[9]); o1.y = pk2(acc[10], acc[11]); o1.z = pk2(acc[12], acc[13]); o1.w = pk2(acc[14], acc[15]);
        *(u32x4*)dst = o0; *(u32x4*)(dst + 8) = o1;
        __syncthreads();
    }
    { float* wrt = (float*)(ws + WS_SMALL + SM_WRT);
      for (int i = blockIdx.x * 512 + F.tid; i < 2 * 48 * D; i += F.G * 512) { const int l = i / (48 * D), c = (i / D) % 48, k = i % D;
          float v = 0.f;
          if (c < 4) v = ap->in[I_WGROUP][(size_t)(l * D + k) * 4 + c]; else if (c < 36) v = ap->in[I_WROUTER][((size_t)(l * 4 + ((c - 4) >> 3)) * D + k) * 8 + ((c - 4) & 7)];
          wrt[i] = v * ap->in[I_GFFN][l * D + k]; } }
    bf16_t* xb = (bf16_t*)(ws + WS_XB); float* rs_all = (float*)(ws + WS_SMALL + SM_RSALL);
    const float* xin = ap->in[I_X]; const float* memin = ap->in[I_MEM];
    f32x4 nv[8];
#define RP_LOAD(row_) do { const float* src_ = (row_) < T ? xin + (size_t)(row_) * D : memin + (size_t)((row_) - T) * D; _Pragma("unroll") for (int i = 0; i < 8; ++i) nv[i] = *(const f32x4*)(src_ + 4 * F.lane + 256 * i); } while (0)
    if (F.gw < NTOK_ALL) RP_LOAD(F.gw);
    for (int row = F.gw; row < NTOK_ALL; row += F.NGW) {
        f32x4 v[8]; float ss = 0.f;
#pragma unroll
        for (int i = 0; i < 8; ++i) v[i] = nv[i];
        if (row + F.NGW < NTOK_ALL) RP_LOAD(row + F.NGW);
#pragma unroll
        for (int i = 0; i < 8; ++i) ss += (v[i][0] * v[i][0] + v[i][1] * v[i][1]) + (v[i][2] * v[i][2] + v[i][3] * v[i][3]);
        ss = wave_sum(ss);
        if (F.lane == 0) rs_all[row] = 1.0f / sqrtf(ss * (1.0f / D) + RMS_EPS);
#pragma unroll
        for (int i = 0; i < 8; ++i) { u32x2 w; w.x = pk2(v[i][0], v[i][1]); w.y = pk2(v[i][2], v[i][3]); *(u32x2*)(xb + (size_t)row * D + 4 * F.lane + 256 * i) = w; }
        if (row < T) {
#pragma unroll
            for (int i = 0; i < 8; ++i) *(unsigned*)(ws + WS_XI8 + (size_t)row * D + 4 * F.lane + 256 * i) = pk4f8(v[i] * X8_SCALE);
        }
    }
}
constexpr int CONV_MOE_ITEMS = 32 * 3 * 256;
__device__ __forceinline__ int memq_busy(int l) { return l == 0 ? 144 : 128; }
__device__ __forceinline__ int conv_moe_split(int G, int l) { return G >= memq_busy(l) + 64 ? (l == 0 ? 22 : 20) * 3 * 256 : CONV_MOE_ITEMS; }
__device__ __forceinline__ void conv_moe(CArgsP ap, Frame& F, int l, int it_lo, int it_hi, int gw, int ngw) {
    unsigned char* ws = ap->ws;
    LAS float* scr = (LAS float*)(F.lds + 16384 + F.wave * 12288);
    bf16_t* w13_t = (bf16_t*)(ws + WS_W13); bf16_t* w2_t = (bf16_t*)(ws + WS_W2);
    constexpr int IT_E = 256;
    const float* gf = ap->in[I_GFFN] + l * D;
    for (int it = it_lo + gw; it < it_hi; it += ngw) {
        int r = it;
        const int e = r / (3 * IT_E); r -= e * 3 * IT_E;
        const int which = r / IT_E; r -= which * IT_E;
        const size_t eoff = (size_t)(l * 32 + e) * D * 512;
        if (which == 0) conv_item8(ap->in[I_W1] + eoff, D, 512, gf, W8_SCALE, (unsigned char*)w13_t, e * 1024, 7, 256, scr, r, F.lane);
        else if (which == 1) conv_item8(ap->in[I_W3] + eoff, D, 512, gf, W8_SCALE, (unsigned char*)w13_t, e * 1024 + 128, 7, 256, scr, r, F.lane);
        else conv_item8(ap->in[I_W2] + eoff, 512, D, nullptr, W28_SCALE, (unsigned char*)w2_t, e * D, 30, 0, scr, r, F.lane);
    }
}

__device__ __forceinline__ float alibi_slope(int i) { return exp2f(-8.0f * (float)(i + 1) / 12.0f); }

typedef short s16x4 __attribute__((ext_vector_type(4)));
constexpr float LOG2E = 1.4426950408889634f;
__device__ __forceinline__ int koff(int key, int ch) { return 256 * key + 16 * (ch ^ ((((key >> 3) & 3) << 2) | (key & 3))); }
__device__ __forceinline__ int voff(int key, int ch) { return 256 * key + 16 * (ch ^ (((key & 3) << 2) | ((key >> 2) & 3))); }
__device__ __forceinline__ s16x4 vtr(LAS const unsigned char* p) { return __builtin_bit_cast(s16x4, __builtin_amdgcn_ds_read_tr16_b64_v4i16((LAS s16x4*)p)); }
__device__ __forceinline__ bf16x8 pack8(float a0, float a1, float a2, float a3, float b0, float b1, float b2, float b3) {
    u32x4 p;
    asm volatile("v_cvt_pk_bf16_f32 %0, %4, %5\n\tv_cvt_pk_bf16_f32 %1, %6, %7\n\tv_cvt_pk_bf16_f32 %2, %8, %9\n\tv_cvt_pk_bf16_f32 %3, %10, %11\n\ts_nop 1"
                 : "=&v"(p[0]), "=&v"(p[1]), "=&v"(p[2]), "=&v"(p[3]) : "v"(a0), "v"(a1), "v"(a2), "v"(a3), "v"(b0), "v"(b1), "v"(b2), "v"(b3));
    return __builtin_bit_cast(bf16x8, p);
}
__device__ __forceinline__ void stage_kv(LAS unsigned char* lds, const bf16_t* Kg, const bf16_t* Vg, int stride, int row0, int step, int minrow, int tid_) {
    int tid = tid_; asm volatile("" : "+v"(tid));
    const int lane = tid & 63, w = __builtin_amdgcn_readfirstlane(tid >> 6), q = lane >> 4, c = lane & 15;
    const int chK = c ^ ((((w >> 1) & 3) << 2) | q), chV = c ^ ((q << 2) | (w & 3));
#pragma unroll
    for (int i = 0; i < 8; ++i) { const int key = 32 * i + 4 * w + q; int row = row0 + key * step; row = row < minrow ? minrow : row;
        const size_t o = (size_t)row * stride;
        __builtin_amdgcn_global_load_lds((const unsigned*)(Kg + o + 8 * chK), (LAS unsigned*)(lds + 256 * (32 * i + 4 * w)), 16, 0, 0);
        __builtin_amdgcn_global_load_lds((const unsigned*)(Vg + o + 8 * chV), (LAS unsigned*)(lds + 65536 + 256 * (32 * i + 4 * w)), 16, 0, 0); }
    asm volatile("s_waitcnt vmcnt(0)" ::: "memory");
}
template <int NP, bool OUT8>
__device__ __forceinline__ void attn_tile_wave(LAS const unsigned char* lds, int kp0, const bf16_t* qptr, float qscale, float Q0, float Dmax, float kmin, float slope2, bool mask_on,
                                               bf16_t* optr, float* mlptr, bool qvalid, int lane) {
    const int n = lane & 15, g = lane >> 4;
    LAS const unsigned char* Kimg = lds; LAS const unsigned char* Vimg = lds + 65536;
    bf16x8 qf[4];
#pragma unroll
    for (int ks = 0; ks < 4; ++ks) qf[ks] = *(const bf16x8*)(qptr + 32 * ks + 8 * g);
    const float kb = (float)(32 * kp0 + 8 * g);
    const float based = Q0 - kb;
    const float lowC = fmaxf(based - Dmax, kmin - kb);
    const float rq = 1.0f / qscale, u = slope2 * rq, b0q = -slope2 * based * rq;
    f32x4 acc[NP][2];
#pragma unroll
    for (int kp = 0; kp < NP; ++kp)
#pragma unroll
        for (int t = 0; t < 2; ++t)
#pragma unroll
            for (int i = 0; i < 4; ++i) acc[kp][t][i] = __builtin_fmaf(u, (float)(32 * kp + 4 * t + i), b0q);
    if (mask_on) {
#pragma unroll
        for (int kp = 0; kp < NP; ++kp)
#pragma unroll
            for (int t = 0; t < 2; ++t)
#pragma unroll
                for (int i = 0; i < 4; ++i) { const float C = (float)(32 * kp + 4 * t + i); acc[kp][t][i] = (C <= based && C >= lowC) ? acc[kp][t][i] : -INFINITY; }
    }
    const int krow = 32 * kp0 + 8 * (n >> 2) + (n & 3);
    {
        bf16x8 kbuf[2][4];
#define LDK(buf, tt) do { const int key_ = krow + 32 * ((tt) >> 1) + 4 * ((tt) & 1); _Pragma("unroll") for (int ks = 0; ks < 4; ++ks) kbuf[buf][ks] = *(LAS const bf16x8*)(Kimg + koff(key_, 4 * ks + g)); } while (0)
        LDK(0, 0);
        __builtin_amdgcn_sched_barrier(0);
#pragma unroll
        for (int tt = 0; tt < 2 * NP; ++tt) {
            if (tt + 1 < 2 * NP) LDK((tt + 1) & 1, tt + 1);
            __builtin_amdgcn_sched_barrier(0);
#pragma unroll
            for (int ks = 0; ks < 4; ++ks) acc[tt >> 1][tt & 1] = __builtin_amdgcn_mfma_f32_16x16x32_bf16(kbuf[tt & 1][ks], qf[ks], acc[tt >> 1][tt & 1], 0, 0, 0);
            __builtin_amdgcn_sched_barrier(0);
        }
#undef LDK
    }
    float m = -INFINITY;
#pragma unroll
    for (int kp = 0; kp < NP; ++kp)
#pragma unroll
        for (int t = 0; t < 2; ++t) m = fmaxf(fmaxf(m, fmaxf(acc[kp][t][0], acc[kp][t][1])), fmaxf(acc[kp][t][2], acc[kp][t][3]));
    m = fmaxf(m, __shfl_xor(m, 16)); m = fmaxf(m, __shfl_xor(m, 32));
    const float mraw = (m == -INFINITY) ? 0.f : m;
    const float ms = mraw * qscale, nms = -ms;
    float lsum = 0.f;
    bf16x8 pf[NP];
#pragma unroll
    for (int kp = 0; kp < NP; ++kp) { float p[8];
#pragma unroll
        for (int t = 0; t < 2; ++t)
#pragma unroll
            for (int i = 0; i < 4; ++i) { p[4 * t + i] = __builtin_amdgcn_exp2f(__builtin_fmaf(acc[kp][t][i], qscale, nms)); lsum += p[4 * t + i]; }
        pf[kp] = pack8(p[0], p[1], p[2], p[3], p[4], p[5], p[6], p[7]); }
    lsum += __shfl_xor(lsum, 16); lsum += __shfl_xor(lsum, 32);
    f32x4 o[8];
#pragma unroll
    for (int dt = 0; dt < 8; ++dt) o[dt] = (f32x4){0.f, 0.f, 0.f, 0.f};
    const int q4 = n >> 2, p4 = n & 3;
    {
        s16x4 vlo[2][4], vhi[2][4];
#define LDV(buf, ss) do { const int r0_ = 32 * (kp0 + ((ss) >> 1)) + 8 * g + q4; _Pragma("unroll") for (int d4 = 0; d4 < 4; ++d4) { const int dt_ = 4 * ((ss) & 1) + d4; \
            vlo[buf][d4] = vtr(Vimg + voff(r0_, 2 * dt_ + (p4 >> 1)) + 8 * (p4 & 1)); vhi[buf][d4] = vtr(Vimg + voff(r0_ + 4, 2 * dt_ + (p4 >> 1)) + 8 * (p4 & 1)); } } while (0)
        LDV(0, 0);
        __builtin_amdgcn_sched_barrier(0);
#pragma unroll
        for (int ss = 0; ss < 2 * NP; ++ss) {
            if (ss + 1 < 2 * NP) LDV((ss + 1) & 1, ss + 1);
            __builtin_amdgcn_sched_barrier(0);
#pragma unroll
            for (int d4 = 0; d4 < 4; ++d4) { const bf16x8 vf = __builtin_shufflevector(vlo[ss & 1][d4], vhi[ss & 1][d4], 0, 1, 2, 3, 4, 5, 6, 7);
                o[4 * (ss & 1) + d4] = __builtin_amdgcn_mfma_f32_16x16x32_bf16(vf, pf[ss >> 1], o[4 * (ss & 1) + d4], 0, 0, 0); }
            __builtin_amdgcn_sched_barrier(0);
        }
#undef LDV
    }
    if (qvalid) {
        const float inv = 1.0f / lsum;
        if (OUT8) {
            const float i16 = inv * 16.0f; int w[8];
#pragma unroll
            for (int dt = 0; dt < 8; ++dt) { int v = 0; v = __builtin_amdgcn_cvt_pk_fp8_f32(o[dt][0] * i16, o[dt][1] * i16, v, false); v = __builtin_amdgcn_cvt_pk_fp8_f32(o[dt][2] * i16, o[dt][3] * i16, v, true); w[dt] = v; }
            u32x4 w0, w1; w0.x = (unsigned)w[0]; w0.y = (unsigned)w[1]; w0.z = (unsigned)w[2]; w0.w = (unsigned)w[3]; w1.x = (unsigned)w[4]; w1.y = (unsigned)w[5]; w1.z = (unsigned)w[6]; w1.w = (unsigned)w[7];
            *(u32x4*)((unsigned char*)optr + 32 * g) = w0; *(u32x4*)((unsigned char*)optr + 32 * g + 16) = w1;
        } else {
#pragma unroll
            for (int dt = 0; dt < 8; ++dt) { u32x2 w; w.x = pk2(o[dt][0] * inv, o[dt][1] * inv); w.y = pk2(o[dt][2] * inv, o[dt][3] * inv); *(u32x2*)(optr + 16 * dt + 4 * g) = w; }
        }
        if (mlptr != nullptr && g == 0) { f32x2 mlv; mlv.x = ms; mlv.y = lsum; *(f32x2*)mlptr = mlv; }
    }
}

__device__ __forceinline__ void phase_inproj(LAS unsigned char* lds, int l) {
    CArgsP ap = kargs(); unsigned char* ws = ap->ws; const int G = gridDim.x;
    {
        pg8::Gemm g{(const bf16_t*)(ws + WS_XI8), (const bf16_t*)(ws + WS_WIN8 + (size_t)l * INC * D), T, INC, D / 2}; pg8::SubsetOrder S; S.so.init(T, 16 * 256, G, (int)blockIdx.x); S.l0 = 12; S.b0 = 0; S.l1 = 4; S.b1 = 14; S.b2 = 0;
        pg8::EpiScaleBf16 E{(bf16_t*)(ws + WS_P), INC, (const float*)(ws + WS_SMALL + SM_RSALL), (float*)(ws + WS_SMALL + SM_KMH), 1.0f / (X8_SCALE * W8_SCALE)};
        pg8::gemm_phase<pg8::EpiScaleBf16, pg8::SubsetOrder, true>(lds, g, S, E);
    }
    __syncthreads();
    {
        pg8::Gemm g{(const bf16_t*)(ws + WS_XB), (const bf16_t*)(ws + WS_WIN) + (size_t)l * INC * D, T, INC, D}; pg8::SubsetOrder S; S.so.init(T, 4 * 256, G, (int)blockIdx.x); S.l0 = 2; S.b0 = 12; S.l1 = 2; S.b1 = 18; S.b2 = 0;
        pg8::EpiScaleBf16 E{(bf16_t*)(ws + WS_P), INC, (const float*)(ws + WS_SMALL + SM_RSALL), (float*)(ws + WS_SMALL + SM_KMH), 1.0f};
        pg8::gemm_phase<pg8::EpiScaleBf16, pg8::SubsetOrder, false>(lds, g, S, E);
    }
}
struct Top3 { float v0, v1, v2; int i0, i1, i2; };
__device__ __forceinline__ bool t3_better(float a, int ai, float b, int bi) { return a > b || (a == b && ai < bi); }
__device__ __forceinline__ void t3_insert(Top3& t, float v, int idx) {
    const bool b0 = t3_better(v, idx, t.v0, t.i0), b1 = t3_better(v, idx, t.v1, t.i1), b2 = t3_better(v, idx, t.v2, t.i2);
    t.v2 = b1 ? t.v1 : (b2 ? v : t.v2); t.i2 = b1 ? t.i1 : (b2 ? idx : t.i2);
    t.v1 = b0 ? t.v0 : (b1 ? v : t.v1); t.i1 = b0 ? t.i0 : (b1 ? idx : t.i1);
    t.v0 = b0 ? v : t.v0; t.i0 = b0 ? idx : t.i0;
}
__device__ __forceinline__ void phase_gate(LAS unsigned char* lds, int l) {
    CArgsP ap = kargs(); Frame F = make_frame(lds); unsigned char* ws = ap->ws;
    const bf16_t* Pb = (const bf16_t*)(ws + WS_P); const float* kpart = (const float*)(ws + WS_SMALL + SM_KMH); bf16_t* mix = (bf16_t*)(ws + WS_MIX);
    int* sel = (int*)(ws + WS_SMALL + SM_SEL); int* list = (int*)(ws + WS_SMALL + SM_LIST); unsigned* lcnt = (unsigned*)(ws + WS_CTL) + CW_LCNT + 512 * CPAD * l;
    const int n16 = F.lane & 15, g = F.lane >> 4;
    for (int item = F.gw; item < 16 * 128; item += F.NGW) {
        const int bh = item >> 7, chunk = item & 127, b = bh >> 3, h = bh & 7, t0 = chunk * 64, own = t0 >> 8;
        bf16x8 kh[2][4], kl[2][4];
#pragma unroll
        for (int t2 = 0; t2 < 2; ++t2)
#pragma unroll
            for (int ks = 0; ks < 4; ++ks) {
                const float* p0 = kpart + (size_t)(b * 32 + 16 * t2 + n16) * 1024 + h * 128 + 32 * ks + 8 * g; const float* p1 = p0 + (size_t)64 * 1024;
                const f32x4 a0 = (*(const f32x4*)p0 + *(const f32x4*)p1) * (1.0f / 256.0f), a1 = (*(const f32x4*)(p0 + 4) + *(const f32x4*)(p1 + 4)) * (1.0f / 256.0f);
                const unsigned h0 = f2bf(a0[0]), h1 = f2bf(a0[1]), h2 = f2bf(a0[2]), h3 = f2bf(a0[3]), h4 = f2bf(a1[0]), h5 = f2bf(a1[1]), h6 = f2bf(a1[2]), h7 = f2bf(a1[3]);
                u32x4 hv; hv.x = h0 | (h1 << 16); hv.y = h2 | (h3 << 16); hv.z = h4 | (h5 << 16); hv.w = h6 | (h7 << 16);
                u32x4 lv; lv.x = pk2(a0[0] - __builtin_bit_cast(float, h0 << 16), a0[1] - __builtin_bit_cast(float, h1 << 16)); lv.y = pk2(a0[2] - __builtin_bit_cast(float, h2 << 16), a0[3] - __builtin_bit_cast(float, h3 << 16));
                lv.z = pk2(a1[0] - __builtin_bit_cast(float, h4 << 16), a1[1] - __builtin_bit_cast(float, h5 << 16)); lv.w = pk2(a1[2] - __builtin_bit_cast(float, h6 << 16), a1[3] - __builtin_bit_cast(float, h7 << 16));
                kh[t2][ks] = __builtin_bit_cast(bf16x8, hv); kl[t2][ks] = __builtin_bit_cast(bf16x8, lv); }
        volatile LAS unsigned* cloc = (volatile LAS unsigned*)(F.lds + F.wave * 256);
        if (F.lane < 32) cloc[F.lane] = 0u;
        LDS_WAIT();
        int pend[4][3];
#pragma unroll
        for (int tile = 0; tile < 4; ++tile) {
            const int tpos = t0 + tile * 16 + n16, row = b * SEQ + tpos;
            bf16x8 qf[4];
#pragma unroll
            for (int ks = 0; ks < 4; ++ks) qf[ks] = *(const bf16x8*)(Pb + (size_t)row * INC + h * 128 + 32 * ks + 8 * g);
            f32x4 acc[2];
#pragma unroll
            for (int t2 = 0; t2 < 2; ++t2) { acc[t2] = (f32x4){0.f, 0.f, 0.f, 0.f};
#pragma unroll
                for (int ks = 0; ks < 4; ++ks) { acc[t2] = __builtin_amdgcn_mfma_f32_16x16x32_bf16(kh[t2][ks], qf[ks], acc[t2], 0, 0, 0);
                    acc[t2] = __builtin_amdgcn_mfma_f32_16x16x32_bf16(kl[t2][ks], qf[ks], acc[t2], 0, 0, 0); } }
            Top3 t; t.v0 = t.v1 = t.v2 = -INFINITY; t.i0 = 64; t.i1 = 65; t.i2 = 66;
#pragma unroll
            for (int t2 = 0; t2 < 2; ++t2)
#pragma unroll
                for (int i = 0; i < 4; ++i) { const int blk = 16 * t2 + 4 * g + i; t3_insert(t, blk < own ? acc[t2][i] : -INFINITY, blk); }
#pragma unroll
            for (int x = 16; x <= 32; x <<= 1) {
                const float p0 = __shfl_xor(t.v0, x), p1 = __shfl_xor(t.v1, x), p2 = __shfl_xor(t.v2, x);
                const int q0 = __shfl_xor(t.i0, x), q1 = __shfl_xor(t.i1, x), q2 = __shfl_xor(t.i2, x);
                t3_insert(t, p0, q0); t3_insert(t, p1, q1); t3_insert(t, p2, q2);
            }
            pend[tile][0] = pend[tile][1] = pend[tile][2] = -1;
            if (g == 0) {
                const int s0 = t.v0 > -INFINITY ? t.i0 : -1, s1 = t.v1 > -INFINITY ? t.i1 : -1, s2 = t.v2 > -INFINITY ? t.i2 : -1;
                sel[(size_t)(row * 8 + h) * 4] = (s0 & 0xff) | ((s1 & 0xff) << 8) | ((s2 & 0xff) << 16);
                if (s0 >= 0) pend[tile][0] = (s0 << 16) | (int)__hip_atomic_fetch_add((LAS unsigned*)cloc + s0, 1u, __ATOMIC_RELAXED, __HIP_MEMORY_SCOPE_WORKGROUP);
                if (s1 >= 0) pend[tile][1] = (s1 << 16) | (int)__hip_atomic_fetch_add((LAS unsigned*)cloc + s1, 1u, __ATOMIC_RELAXED, __HIP_MEMORY_SCOPE_WORKGROUP);
                if (s2 >= 0) pend[tile][2] = (s2 << 16) | (int)__hip_atomic_fetch_add((LAS unsigned*)cloc + s2, 1u, __ATOMIC_RELAXED, __HIP_MEMORY_SCOPE_WORKGROUP);
            }
        }
        LDS_WAIT();
        if (F.lane < 32) { const unsigned c = cloc[F.lane];
            cloc[32 + F.lane] = c ? __hip_atomic_fetch_add(lcnt + (bh * 32 + F.lane) * CPAD, c, __ATOMIC_RELAXED, __HIP_MEMORY_SCOPE_AGENT) : 0u; }
        LDS_WAIT();
        if (g == 0) {
#pragma unroll
            for (int tile = 0; tile < 4; ++tile)
#pragma unroll
                for (int k = 0; k < 3; ++k) { const int pe = pend[tile][k];
                    if (pe >= 0) { const int blk = pe >> 16; list[(size_t)(bh * 32 + blk) * 8192 + cloc[32 + blk] + (unsigned)(pe & 0xffff)] = ((t0 + tile * 16 + n16) << 2) | k; } }
        }
        LDS_WAIT();
    }
    for (int item = F.gw; item < (T / 32) * 4; item += F.NGW) {
        const int g = item & 3, row0 = (item >> 2) * 32, t0 = row0 & (SEQ - 1), w = 2 << g;
        const bf16_t* up = Pb + 4608 + g * 128 + 2 * F.lane;
        float s0 = 0.f, s1 = 0.f;
        const int nin = t0 < w ? t0 : w;
#pragma unroll
        for (int i = 0; i < 16; ++i) if (i < nin) { const unsigned u = *(const unsigned*)(up + (size_t)(row0 - 1 - i) * INC); s0 += bf_lo(u); s1 += bf_hi(u); }
#pragma unroll
        for (int i = 0; i < 32; ++i) { const int row = row0 + i, tpos = t0 + i;
            const unsigned ut = *(const unsigned*)(up + (size_t)row * INC);
            const int rold = tpos >= w ? row - w : row;
            const unsigned uo = *(const unsigned*)(up + (size_t)rold * INC);
            s0 += bf_lo(ut); s1 += bf_hi(ut);
            if (tpos >= w) { s0 -= bf_lo(uo); s1 -= bf_hi(uo); }
            const float inv = 1.0f / (float)(tpos + 1 < w ? tpos + 1 : w);
            *(unsigned*)(mix + (size_t)row * D + 1536 + g * 128 + 2 * F.lane) = pk2(s0 * inv - bf_lo(ut), s1 * inv - bf_hi(ut)); }
    }
    conv_moe(ap, F, l, 0, conv_moe_split(F.G, l), F.gw, F.NGW);
}
__device__ __forceinline__ void phase_attn_tiles(LAS unsigned char* lds, int l) {
    CArgsP ap = kargs(); Frame F = make_frame(lds); unsigned char* ws = ap->ws;
    const bf16_t* Pb = (const bf16_t*)(ws + WS_P); const int* list = (const int*)(ws + WS_SMALL + SM_LIST); const unsigned* lcnt = (const unsigned*)(ws + WS_CTL) + CW_LCNT + 512 * CPAD * l;
    bf16_t* OP = (bf16_t*)(ws + WS_OP); float* ML = (float*)(ws + WS_SMALL + SM_ML);
    LAS int* pre = (LAS int*)(F.lds + MISC_OFF + 1024);
    LAS int* tmp = (LAS int*)F.lds;
    tmp[F.tid] = 1 + (int)((lcnt[F.tid * CPAD] + 255u) >> 8);
    __syncthreads();
    { int sum = 0; for (int k = 0; k < F.tid; ++k) sum += tmp[k]; pre[F.tid] = sum; if (F.tid == 511) pre[512] = sum + tmp[511]; }
    __syncthreads();
    const int n_moba = pre[512], n_total = n_moba + 1536;
    const int n = F.lane & 15;
    const int vb = (F.G & 7) == 0 ? ((int)blockIdx.x & 7) * (F.G >> 3) + ((int)blockIdx.x >> 3) : (int)blockIdx.x;
    for (int t = vb; t < n_moba; t += F.G) {
        int lo_i = 0, hi_i = 512;
        while (hi_i - lo_i > 1) { const int mid = (lo_i + hi_i) >> 1; if (pre[mid] <= t) lo_i = mid; else hi_i = mid; }
        const int li = lo_i, ti = t - pre[li];
        const int b = li >> 8, h = (li >> 5) & 7, j = li & 31;
        stage_kv(F.lds, Pb + 1024 + h * 128, Pb + 2048 + h * 128, INC, b * SEQ + j * 256, 1, 0, F.tid);
        const float slope2 = alibi_slope(h + (h >> 1)) * LOG2E;
        const int cntl = (int)lcnt[li * CPAD];
        __syncthreads();
#pragma unroll 1
        for (int sb = 0; sb < 2; ++sb) {
            int tpos, slot; bool qv = true;
            if (ti == 0) { tpos = j * 256 + sb * 128 + F.wave * 16 + n; slot = 3; }
            else { int idx = (ti - 1) * 256 + sb * 128 + F.wave * 16 + n; qv = idx < cntl; idx = qv ? idx : cntl - 1;
                const int e = list[(size_t)li * 8192 + idx]; tpos = e >> 2; slot = e & 3; }
            if (ti > 0 && (ti - 1) * 256 + sb * 128 >= cntl) break;
            const int row = b * SEQ + tpos;
            const size_t pslot = ((size_t)row * 12 + h) * 4 + slot;
            attn_tile_wave<8, true>(F.lds, 0, Pb + (size_t)row * INC + h * 128, ATT_SCALE * LOG2E, (float)(tpos - j * 256), 1.0e9f, 0.f, slope2, ti == 0, OP + pslot * 64, ML + pslot * 2, qv, F.lane);
        }
        __syncthreads();
    }
    int d0 = (vb - n_moba) % F.G; if (d0 < 0) d0 += F.G;
    for (int d = d0; d < 1536; d += F.G) {
        const int idx64 = d & 63, rest = d >> 6, br = rest % 3, bh = rest / 3, hb = bh & 3, b = bh >> 2;
        const int dil = 1 << (2 * br), nb = 64 >> (2 * br);
        const int r = idx64 / nb, cb = idx64 - r * nb;
        stage_kv(F.lds, Pb + 3584 + hb * 128, Pb + 4096 + hb * 128, INC, b * SEQ + (128 * cb - 128) * dil + r, dil, b * SEQ, F.tid);
        const int tpos = (128 * cb + 16 * F.wave + n) * dil + r, row = b * SEQ + tpos;
        const float slope2 = alibi_slope(3 * hb + 2) * (float)dil * LOG2E;
        const size_t pslot = ((size_t)row * 12 + 8 + hb) * 4 + br;
        __syncthreads();
        attn_tile_wave<5, true>(F.lds, F.wave >> 1, Pb + (size_t)row * INC + 3072 + hb * 128, ATT_SCALE * LOG2E, (float)(128 + 16 * F.wave + n), 128.f, cb == 0 ? 128.f : 0.f, slope2, true,
                          OP + pslot * 64, ML + pslot * 2, true, F.lane);
        __syncthreads();
    }
}
__device__ __forceinline__ void phase_attn_combine(LAS unsigned char* lds, int l) {
    CArgsP ap = kargs(); Frame F = make_frame(lds); unsigned char* ws = ap->ws;
    const bf16_t* OP = (const bf16_t*)(ws + WS_OP); const float* ML = (const float*)(ws + WS_SMALL + SM_ML); const int* sel = (const int*)(ws + WS_SMALL + SM_SEL);
    bf16_t* mix = (bf16_t*)(ws + WS_MIX);
    const int sub = F.lane & 15, grp = F.lane >> 4;
#pragma unroll 4
    for (int item = F.gw; item < T * 3; item += F.NGW) {
        const int idx = item * 4 + grp, row = idx / 12, hh = idx - row * 12;
        const bool moba = hh < 8;
        const int selw = moba ? sel[(size_t)(row * 8 + hh) * 4] : 0;
        f32x2 mlv[4]; u32x2 uu[4];
#pragma unroll
        for (int sidx = 0; sidx < 4; ++sidx) { mlv[sidx] = (f32x2){0.f, 0.f}; uu[sidx] = (u32x2){0u, 0u};
            if (moba || sidx < 3) { mlv[sidx] = *(const f32x2*)(ML + ((size_t)idx * 4 + sidx) * 2); uu[sidx] = *(const u32x2*)((const unsigned char*)OP + ((size_t)idx * 4 + sidx) * 128 + sub * 8); } }
        bool val[4]; float mm[4], ll[4];
#pragma unroll
        for (int sidx = 0; sidx < 4; ++sidx) {
            const bool v = moba ? ((sidx == 3) ? true : (((selw >> (8 * sidx)) & 0xff) != 0xff)) : sidx < 3;
            val[sidx] = v; mm[sidx] = v ? mlv[sidx].x : -INFINITY; ll[sidx] = v ? mlv[sidx].y : 0.f;
        }
        const float M = fmaxf(fmaxf(mm[0], mm[1]), fmaxf(mm[2], mm[3]));
        float wsum = 0.f, wgt[4];
#pragma unroll
        for (int sidx = 0; sidx < 4; ++sidx) { wgt[sidx] = val[sidx] ? ll[sidx] * __builtin_amdgcn_exp2f(mm[sidx] - M) : 0.f; wsum += wgt[sidx]; }
        const float inv = 1.0f / wsum;
        float o[8] = {0.f, 0.f, 0.f, 0.f, 0.f, 0.f, 0.f, 0.f};
#pragma unroll
        for (int sidx = 0; sidx < 4; ++sidx) { const u32x2 u = uu[sidx]; const float w = wgt[sidx] * inv * (1.0f / 16.0f);
            const f32x2 a = __builtin_amdgcn_cvt_pk_f32_fp8((int)u.x, false), b = __builtin_amdgcn_cvt_pk_f32_fp8((int)u.x, true), c = __builtin_amdgcn_cvt_pk_f32_fp8((int)u.y, false), d = __builtin_amdgcn_cvt_pk_f32_fp8((int)u.y, true);
            o[0] += w * a.x; o[1] += w * a.y; o[2] += w * b.x; o[3] += w * b.y; o[4] += w * c.x; o[5] += w * c.y; o[6] += w * d.x; o[7] += w * d.y; }
        const int D0 = 32 * (sub & 3) + 4 * (sub >> 2);
        u32x2 wa, wb; wa.x = pk2(o[0], o[1]); wa.y = pk2(o[2], o[3]); wb.x = pk2(o[4], o[5]); wb.y = pk2(o[6], o[7]);
        *(u32x2*)(mix + (size_t)row * D + hh * 128 + D0) = wa; *(u32x2*)(mix + (size_t)row * D + hh * 128 + D0 + 16) = wb;
    }
}
__device__ __forceinline__ void phase_outproj(LAS unsigned char* lds, int l) {
    CArgsP ap = kargs(); unsigned char* ws = ap->ws; const int G = gridDim.x;
    pg8::Gemm g{(const bf16_t*)(ws + WS_MIX), (const bf16_t*)(ws + WS_WOUT) + (size_t)l * D * D, T, D, D}; pg8::StaticOrder S; S.init(T, D, G, (int)blockIdx.x);
    pg8::EpiRes E{(bf16_t*)(ws + WS_XB), (float*)(ws + WS_SMALL + SM_SSQP), nullptr};
    pg8::gemm_phase<pg8::EpiRes, pg8::StaticOrder>(lds, g, S, E);
}
__device__ __forceinline__ void phase_memq(LAS unsigned char* lds, int l) {
    CArgsP ap = kargs(); unsigned char* ws = ap->ws; const int G = gridDim.x;
    pg8::Gemm g{(const bf16_t*)(ws + WS_XB), (const bf16_t*)(ws + WS_WC) + (size_t)(l ? 2560 : 0) * D, T, 512, D}; pg8::P7Order S{G, (int)blockIdx.x, 128, l == 0 ? 16 : 0};
    pg8::EpiP7 E{(bf16_t*)(ws + WS_QC), (bf16_t*)(ws + WS_KVC), (const float*)(ws + WS_SMALL + SM_RSALL)};
    pg8::gemm_phase<pg8::EpiP7, pg8::P7Order>(lds, g, S, E);
    const int nb = memq_busy(l);
    if ((int)blockIdx.x >= nb) { Frame F = make_frame(lds); conv_moe(ap, F, l, conv_moe_split(G, l), CONV_MOE_ITEMS, ((int)blockIdx.x - nb) * 8 + F.wave, (G - nb) * 8); }
}
__device__ __forceinline__ void phase_cross(LAS unsigned char* lds, int l) {
    CArgsP ap = kargs(); Frame F = make_frame(lds); unsigned char* ws = ap->ws;
    const bf16_t* qc = (const bf16_t*)(ws + WS_QC); bf16_t* oc = (bf16_t*)(ws + WS_OC); const float* ssqp = (const float*)(ws + WS_SMALL + SM_SSQP);
    const bf16_t* Kb = (const bf16_t*)(ws + WS_KVC) + (size_t)l * 512 * 1024;
    const int n = F.lane & 15;
    int staged = -1;
    for (int t = blockIdx.x; t < 512; t += F.G) {
        const int bh = t & 7, qt = t >> 3, b = bh >> 2, h = bh & 3;
        if (bh != staged) { __syncthreads(); stage_kv(F.lds, Kb + h * 128, Kb + 512 + h * 128, 1024, b * 256, 1, 0, F.tid); staged = bh; __syncthreads(); }
        const int row = b * SEQ + qt * 128 + F.wave * 16 + n;
        float ss = 0.f;
#pragma unroll
        for (int i = 0; i < 8; ++i) { const f32x4 pv = *(const f32x4*)(ssqp + (size_t)row * 32 + 4 * i); ss += (pv[0] + pv[1]) + (pv[2] + pv[3]); }
        const float rs = 1.0f / sqrtf(ss * (1.0f / D) + RMS_EPS);
        attn_tile_wave<8, false>(F.lds, 0, qc + (size_t)row * 512 + h * 128, ATT_SCALE * LOG2E * rs, 1.0e6f, 1.0e9f, 0.f, 0.f, false, oc + (size_t)row * 512 + h * 128, nullptr, true, F.lane);
    }
    __syncthreads();
}
__device__ __forceinline__ void phase_memo(LAS unsigned char* lds, int l) {
    CArgsP ap = kargs(); unsigned char* ws = ap->ws; const int G = gridDim.x;
    pg8::Gemm g{(const bf16_t*)(ws + WS_OC), (const bf16_t*)(ws + WS_WMO) + (size_t)l * D * 512, T, D, 512}; pg8::StaticOrder S; S.init(T, D, G, (int)blockIdx.x);
    pg8::EpiRes E{(bf16_t*)(ws + WS_XB), (float*)(ws + WS_SMALL + SM_SSQP), ws + WS_X8};
    pg8::gemm_phase<pg8::EpiRes, pg8::StaticOrder>(lds, g, S, E);
}
__device__ __forceinline__ void phase_router(LAS unsigned char* lds, int l) {
    CArgsP ap = kargs(); Frame F = make_frame(lds); unsigned char* ws = ap->ws;
    const bf16_t* xbp = (const bf16_t*)(ws + WS_XB); const float* wrt = (const float*)(ws + WS_SMALL + SM_WRT) + (size_t)l * 48 * D;
    int* tok_e = (int*)(ws + WS_SMALL + SM_TOKE); int* tok_rank = (int*)(ws + WS_SMALL + SM_TOKRANK); float* tok_w = (float*)(ws + WS_SMALL + SM_TOKW); float* rs3 = (float*)(ws + WS_SMALL + SM_RS3);
    unsigned* cnt = (unsigned*)(ws + WS_CTL) + CW_CNT + 32 * CPAD * l;
    const float* bg = ap->in[I_BGROUP] + l * 4; const float* br = ap->in[I_BROUTER] + l * 32;
    const int w8 = F.wave, tl = F.wave & 3, r16 = F.lane & 15, q = F.lane >> 4;
    constexpr int PLS = 16 * 49 + 16;
    LAS float* Pw = (LAS float*)F.lds + (w8 * 4) * PLS;
    for (int base = blockIdx.x * 64; base < T; base += F.G * 64) {
        const bf16_t* xa = xbp + (size_t)(base + r16) * D + w8 * 256 + 4 * q;
        const float* wb = wrt + (size_t)r16 * D + w8 * 256 + 4 * q;
        f32x4 acc[4][3]; float ssq[4];
#pragma unroll
        for (int rt = 0; rt < 4; ++rt) { ssq[rt] = 0.f; acc[rt][0] = acc[rt][1] = acc[rt][2] = (f32x4){0.f, 0.f, 0.f, 0.f}; }
        u32x2 abr[2][2][4]; f32x4 br_[2][2][3];
#define RT_LOAD(buf, u0) do { _Pragma("unroll") for (int i_ = 0; i_ < 2; ++i_) { const int u_ = (u0) + i_; \
            _Pragma("unroll") for (int ct = 0; ct < 3; ++ct) br_[buf][i_][ct] = *(const f32x4*)(wb + (size_t)(16 * ct) * D + 16 * u_); \
            _Pragma("unroll") for (int rt = 0; rt < 4; ++rt) abr[buf][i_][rt] = *(const u32x2*)(xa + (size_t)(16 * rt) * D + 16 * u_); } } while (0)
#define RT_MMA(buf) do { _Pragma("unroll") for (int i_ = 0; i_ < 2; ++i_) _Pragma("unroll") for (int rt = 0; rt < 4; ++rt) { const u32x2 ab = abr[buf][i_][rt]; \
            const f32x4 a = (f32x4){bf_lo(ab.x), bf_hi(ab.x), bf_lo(ab.y), bf_hi(ab.y)}; ssq[rt] += (a[0] * a[0] + a[1] * a[1]) + (a[2] * a[2] + a[3] * a[3]); \
            _Pragma("unroll") for (int j = 0; j < 4; ++j) _Pragma("unroll") for (int ct = 0; ct < 3; ++ct) acc[rt][ct] = __builtin_amdgcn_mfma_f32_16x16x4f32(a[j], br_[buf][i_][ct][j], acc[rt][ct], 0, 0, 0); } } while (0)
        RT_LOAD(0, 0);
#pragma unroll 1
        for (int ug = 0; ug < 8; ug += 2) {
            RT_LOAD(1, 2 * ug + 2);
            __builtin_amdgcn_sched_barrier(0);
            RT_MMA(0);
            __builtin_amdgcn_sched_barrier(0);
            if (ug + 2 < 8) RT_LOAD(0, 2 * ug + 4);
            __builtin_amdgcn_sched_barrier(0);
            RT_MMA(1);
            __builtin_amdgcn_sched_barrier(0);
        }
#undef RT_LOAD
#undef RT_MMA
#pragma unroll
        for (int rt = 0; rt < 4; ++rt) { float sq = ssq[rt]; sq += __shfl_xor(sq, 16); sq += __shfl_xor(sq, 32);
            LAS float* Pl = Pw + rt * PLS;
#pragma unroll
            for (int ct = 0; ct < 3; ++ct)
#pragma unroll
                for (int i = 0; i < 4; ++i) Pl[(4 * q + i) * 49 + 16 * ct + r16] = acc[rt][ct][i];
            if (q == 0) Pl[16 * 49 + r16] = sq; }
        volatile LAS unsigned* ecl = (volatile LAS unsigned*)(F.lds + 110592);
        if (F.tid < 32) ecl[F.tid] = 0u;
        __syncthreads();
        int t_e0 = 0, t_e1 = 0, t_row = 0; unsigned t_r0 = 0, t_r1 = 0; float t_w0 = 0.f, t_w1 = 0.f, t_rs = 0.f;
        const bool tailer = F.wave < 4 && F.lane < 16;
        if (tailer) {
            const LAS float* P0 = (const LAS float*)F.lds + tl * PLS;
            const int row = base + tl * 16 + F.lane;
            float sst = 0.f;
#pragma unroll
            for (int w = 0; w < 8; ++w) sst += P0[w * 4 * PLS + 16 * 49 + F.lane];
            const float rs = 1.0f / sqrtf(sst * (1.0f / D) + RMS_EPS);
            const LAS float* a0 = P0 + F.lane * 49;
#define RT_SUM(c_) (((a0[(c_)] + a0[4 * PLS + (c_)]) + (a0[8 * PLS + (c_)] + a0[12 * PLS + (c_)])) + ((a0[16 * PLS + (c_)] + a0[20 * PLS + (c_)]) + (a0[24 * PLS + (c_)] + a0[28 * PLS + (c_)])))
            float gl[4];
#pragma unroll
            for (int j = 0; j < 4; ++j) gl[j] = RT_SUM(j) * rs + bg[j];
            int gsel = 0; float gmax = gl[0];
#pragma unroll
            for (int j = 1; j < 4; ++j) if (gl[j] > gmax) { gmax = gl[j]; gsel = j; }
            float gden = 0.f;
#pragma unroll
            for (int j = 0; j < 4; ++j) gden += __expf(gl[j] - gmax);
            const float gwt = 1.0f / gden;
            float el[8];
#pragma unroll
            for (int j = 0; j < 8; ++j) el[j] = RT_SUM(4 + gsel * 8 + j) * rs + br[gsel * 8 + j];
            float v0 = el[0]; int i0 = 0;
#pragma unroll
            for (int j = 1; j < 8; ++j) if (el[j] > v0) { v0 = el[j]; i0 = j; }
            float v1 = -INFINITY; int i1 = 0;
#pragma unroll
            for (int j = 0; j < 8; ++j) if (j != i0 && el[j] > v1) { v1 = el[j]; i1 = j; }
            const float p0 = 1.0f / (1.0f + __expf(v1 - v0)), p1 = 1.0f - p0;
            const int e0 = gsel * 8 + i0, e1 = gsel * 8 + i1;
            t_r0 = __hip_atomic_fetch_add((LAS unsigned*)ecl + e0, 1u, __ATOMIC_RELAXED, __HIP_MEMORY_SCOPE_WORKGROUP);
            t_r1 = __hip_atomic_fetch_add((LAS unsigned*)ecl + e1, 1u, __ATOMIC_RELAXED, __HIP_MEMORY_SCOPE_WORKGROUP);
            t_e0 = e0; t_e1 = e1; t_row = row; t_w0 = p0 * gwt; t_w1 = p1 * gwt; t_rs = rs;
#undef RT_SUM
        }
        __syncthreads();
        if (F.tid < 32) { const unsigned c = ecl[F.tid]; ecl[32 + F.tid] = c ? __hip_atomic_fetch_add(cnt + F.tid * CPAD, c, __ATOMIC_RELAXED, __HIP_MEMORY_SCOPE_AGENT) : 0u; }
        __syncthreads();
        if (tailer) {
            const unsigned k0 = ecl[32 + t_e0] + t_r0, k1 = ecl[32 + t_e1] + t_r1;
            tok_e[t_row * 2] = t_e0; tok_e[t_row * 2 + 1] = t_e1; tok_rank[t_row * 2] = (int)k0; tok_rank[t_row * 2 + 1] = (int)k1;
            tok_w[t_row * 2] = t_w0; tok_w[t_row * 2 + 1] = t_w1; rs3[t_row] = t_rs;
        }
        __syncthreads();
    }
}
__device__ __forceinline__ void phase_scatter(LAS unsigned char* lds, int l) {
    CArgsP ap = kargs(); Frame F = make_frame(lds); unsigned char* ws = ap->ws;
    const int* tok_e = (const int*)(ws + WS_SMALL + SM_TOKE); const int* tok_rank = (const int*)(ws + WS_SMALL + SM_TOKRANK); const float* tok_w = (const float*)(ws + WS_SMALL + SM_TOKW);
    const float* rs3 = (const float*)(ws + WS_SMALL + SM_RS3); int* tokrow = (int*)(ws + WS_SMALL + SM_TOKROW); f32x4* rowinfo = (f32x4*)(ws + WS_SMALL + SM_ROWINFO);
    int* panel_e = (int*)(ws + WS_SMALL + SM_PANEL); unsigned* cnt = (unsigned*)(ws + WS_CTL) + CW_CNT + 32 * CPAD * l;
    const bf16_t* xb = (const bf16_t*)(ws + WS_XB); bf16_t* XG = (bf16_t*)(ws + WS_P);
    LAS int* offs = (LAS int*)F.lds;
    if (F.tid == 0) { int o = 0; for (int e = 0; e < 32; ++e) { const int c = (int)__hip_atomic_load(cnt + e * CPAD, __ATOMIC_RELAXED, __HIP_MEMORY_SCOPE_AGENT); offs[e] = o; offs[64 + e] = c; o += (c + 255) & ~255; } offs[32] = o; }
    __syncthreads();
    int* rowtok = (int*)(ws + WS_SMALL + SM_ROWTOK);
    for (int item = blockIdx.x * 512 + F.tid; item < T * 2; item += F.G * 512) {
        const int row = item >> 1;
        const int e = tok_e[item], rank = tok_rank[item]; const int pos = offs[e] + rank;
        rowinfo[pos] = (f32x4){__builtin_bit_cast(float, row), tok_w[item], rs3[row], 0.f}; tokrow[item] = pos; rowtok[pos] = row;
    }
    for (int idx = blockIdx.x * 512 + F.tid; idx < 32 * 256; idx += F.G * 512) {
        const int e = idx >> 8, r = idx & 255; const int pos = offs[e] + offs[64 + e] + r;
        if (pos < offs[e + 1]) { float z = 0.f; asm volatile("" : "+v"(z)); rowinfo[pos] = (f32x4){z, z, z, z}; rowtok[pos] = 0; }
    }
    if (blockIdx.x == 0) {
        const int np = offs[32] >> 8;
        for (int p = F.tid; p < np; p += 512) { int e = 0;
            for (int k = 0; k < 32; ++k) if (offs[k] <= p * 256 && p * 256 < offs[k + 1]) e = k;
            panel_e[p] = e; }
        if (F.tid == 0) panel_e[200] = np;
    }
    __syncthreads();
}
constexpr int MOE_G1 = 128, MOE_SKIP = 3;
__device__ __forceinline__ void phase_moe_a(LAS unsigned char* lds, int l) {
    CArgsP ap = kargs(); unsigned char* ws = ap->ws; const int G = gridDim.x;
    const int* panel_e = (const int*)(ws + WS_SMALL + SM_PANEL);
    const int np = __builtin_amdgcn_readfirstlane(panel_e[200]); const int n1 = np < MOE_G1 ? np : MOE_G1;
    pg8::Gemm g{(const bf16_t*)(ws + WS_X8), (const bf16_t*)(ws + WS_W13), MAXROWS, 32 * 1024, D / 2}; pg8::GroupedOrder S{G, (int)blockIdx.x, 4, panel_e, 0, n1};
    pg8::EpiMoe1 E{ws + WS_H, (const f32x4*)(ws + WS_SMALL + SM_ROWINFO), 1.0f / (X8_SCALE * W8_SCALE)};
    pg8::gemm_phase_gather<pg8::EpiMoe1, pg8::GroupedOrder, true>(lds, g, S, E, (const int*)(ws + WS_SMALL + SM_ROWTOK));
}
__device__ __forceinline__ void phase_moe_b(LAS unsigned char* lds, int l) {
    CArgsP ap = kargs(); unsigned char* ws = ap->ws; const int G = gridDim.x;
    const int* panel_e = (const int*)(ws + WS_SMALL + SM_PANEL);
    const int np = __builtin_amdgcn_readfirstlane(panel_e[200]); const int n1 = np < MOE_G1 ? np : MOE_G1, n2 = np - n1;
    int nlong = n2 * 4; if (nlong > G) nlong = G;
    if (n2 * 4 <= G) {
        pg8::Gemm g{(const bf16_t*)(ws + WS_X8), (const bf16_t*)(ws + WS_W13), MAXROWS, 32 * 1024, D / 2}; pg8::OneUnitOrder S{(int)blockIdx.x, 4, panel_e, n1, n2 * 4};
        pg8::EpiMoe1 E{ws + WS_H, (const f32x4*)(ws + WS_SMALL + SM_ROWINFO), 1.0f / (X8_SCALE * W8_SCALE)};
        pg8::gemm_phase_gather<pg8::EpiMoe1, pg8::OneUnitOrder, true>(lds, g, S, E, (const int*)(ws + WS_SMALL + SM_ROWTOK));
    } else {
        pg8::Gemm g{(const bf16_t*)(ws + WS_X8), (const bf16_t*)(ws + WS_W13), MAXROWS, 32 * 1024, D / 2}; pg8::GroupedOrder S{G, (int)blockIdx.x, 4, panel_e, n1, n2};
        pg8::EpiMoe1 E{ws + WS_H, (const f32x4*)(ws + WS_SMALL + SM_ROWINFO), 1.0f / (X8_SCALE * W8_SCALE)};
        pg8::gemm_phase_gather<pg8::EpiMoe1, pg8::GroupedOrder, true>(lds, g, S, E, (const int*)(ws + WS_SMALL + SM_ROWTOK));
    }
    __syncthreads();
    {
        pg8::Gemm g{(const bf16_t*)(ws + WS_H), (const bf16_t*)(ws + WS_W2), MAXROWS, 32 * D, 256}; pg8::GroupedSkewOrder S{G, (int)blockIdx.x, 8, panel_e, n1, nlong, MOE_SKIP};
        pg8::EpiMoe2 E{(bf16_t*)(ws + WS_P), 1.0f / (H8_SCALE * W28_SCALE)};
        pg8::gemm_phase<pg8::EpiMoe2, pg8::GroupedSkewOrder, true>(lds, g, S, E);
    }
}
__device__ __forceinline__ void phase_moe_c(LAS unsigned char* lds, int l) {
    CArgsP ap = kargs(); unsigned char* ws = ap->ws; const int G = gridDim.x;
    const int* panel_e = (const int*)(ws + WS_SMALL + SM_PANEL);
    const int np = __builtin_amdgcn_readfirstlane(panel_e[200]); const int n1 = np < MOE_G1 ? np : MOE_G1, n2 = np - n1;
    pg8::Gemm g{(const bf16_t*)(ws + WS_H), (const bf16_t*)(ws + WS_W2), MAXROWS, 32 * D, 256}; pg8::GroupedOrder S{G, (int)blockIdx.x, 8, panel_e, n1, n2};
    pg8::EpiMoe2 E{(bf16_t*)(ws + WS_P), 1.0f / (H8_SCALE * W28_SCALE)};
    pg8::gemm_phase<pg8::EpiMoe2, pg8::GroupedOrder, true>(lds, g, S, E);
}
__device__ __forceinline__ void phase_combine(LAS unsigned char* lds, int l) {
    CArgsP ap = kargs(); Frame F = make_frame(lds); unsigned char* ws = ap->ws;
    bf16_t* xb = (bf16_t*)(ws + WS_XB); float* rs_all = (float*)(ws + WS_SMALL + SM_RSALL);
    const int* tokrow = (const int*)(ws + WS_SMALL + SM_TOKROW); const bf16_t* YG = (const bf16_t*)(ws + WS_P);
    const float* gfin = ap->in[I_GFINAL]; float* outp = ap->out;
    u32x4 dx[4], dy0[4], dy1[4];
#define CB_LOAD(row_, r0_, r1_) do { _Pragma("unroll") for (int i = 0; i < 4; ++i) { const int c0 = 8 * F.lane + 512 * i; \
        dx[i] = *(const u32x4*)(xb + (size_t)(row_) * D + c0); dy0[i] = *(const u32x4*)(YG + (size_t)(r0_) * D + c0); dy1[i] = *(const u32x4*)(YG + (size_t)(r1_) * D + c0); } } while (0)
    int rowB = F.gw + F.NGW, tB0 = 0, tB1 = 0;
    if (F.gw < T) { const int t0 = tokrow[F.gw * 2], t1 = tokrow[F.gw * 2 + 1]; if (rowB < T) { tB0 = tokrow[rowB * 2]; tB1 = tokrow[rowB * 2 + 1]; } CB_LOAD(F.gw, t0, t1); }
    for (int row = F.gw; row < T; row += F.NGW) {
        u32x4 cx[4], cy0[4], cy1[4];
#pragma unroll
        for (int i = 0; i < 4; ++i) { cx[i] = dx[i]; cy0[i] = dy0[i]; cy1[i] = dy1[i]; }
        { const int rowC = rowB + F.NGW; int tC0 = 0, tC1 = 0;
          if (rowC < T) { tC0 = tokrow[rowC * 2]; tC1 = tokrow[rowC * 2 + 1]; }
          if (rowB < T) CB_LOAD(rowB, tB0, tB1);
          rowB = rowC; tB0 = tC0; tB1 = tC1; }
        float v[4][8]; float ss = 0.f;
#pragma unroll
        for (int i = 0; i < 4; ++i) { const int c0 = 8 * F.lane + 512 * i;
            const u32x4 xa = cx[i], ya = cy0[i], yb = cy1[i];
            v[i][0] = bf_lo(xa.x) + bf_lo(ya.x) + bf_lo(yb.x); v[i][1] = bf_hi(xa.x) + bf_hi(ya.x) + bf_hi(yb.x);
            v[i][2] = bf_lo(xa.y) + bf_lo(ya.y) + bf_lo(yb.y); v[i][3] = bf_hi(xa.y) + bf_hi(ya.y) + bf_hi(yb.y);
            v[i][4] = bf_lo(xa.z) + bf_lo(ya.z) + bf_lo(yb.z); v[i][5] = bf_hi(xa.z) + bf_hi(ya.z) + bf_hi(yb.z);
            v[i][6] = bf_lo(xa.w) + bf_lo(ya.w) + bf_lo(yb.w); v[i][7] = bf_hi(xa.w) + bf_hi(ya.w) + bf_hi(yb.w);
#pragma unroll
            for (int j = 0; j < 8; ++j) ss += v[i][j] * v[i][j]; }
        ss = wave_sum(ss);
        const float rs = 1.0f / sqrtf(ss * (1.0f / D) + RMS_EPS);
        if (l == 1) {
#pragma unroll
            for (int i = 0; i < 4; ++i) { const int c0 = 8 * F.lane + 512 * i; const f32x4 g0 = *(const f32x4*)(gfin + c0), g1 = *(const f32x4*)(gfin + c0 + 4);
                *(f32x4*)(outp + (size_t)row * D + c0) = (f32x4){v[i][0] * rs * g0[0], v[i][1] * rs * g0[1], v[i][2] * rs * g0[2], v[i][3] * rs * g0[3]};
                *(f32x4*)(outp + (size_t)row * D + c0 + 4) = (f32x4){v[i][4] * rs * g1[0], v[i][5] * rs * g1[1], v[i][6] * rs * g1[2], v[i][7] * rs * g1[3]}; }
        } else {
            if (F.lane == 0) rs_all[row] = rs;
#pragma unroll
            for (int i = 0; i < 4; ++i) { const int c0 = 8 * F.lane + 512 * i;
                u32x4 w; w.x = pk2(v[i][0], v[i][1]); w.y = pk2(v[i][2], v[i][3]); w.z = pk2(v[i][4], v[i][5]); w.w = pk2(v[i][6], v[i][7]);
                *(u32x4*)(xb + (size_t)row * D + c0) = w;
                u32x2 q8; q8.x = pk4f8((f32x4){v[i][0], v[i][1], v[i][2], v[i][3]} * X8_SCALE); q8.y = pk4f8((f32x4){v[i][4], v[i][5], v[i][6], v[i][7]} * X8_SCALE);
                *(u32x2*)(ws + WS_XI8 + (size_t)row * D + c0) = q8; }
        }
    }
#undef CB_LOAD
}

constexpr int NPL = 14;
constexpr int NPH = 1 + 2 * NPL;
#ifndef DBG_MASK
#define DBG_MASK 0x7fff
#endif
#define PHEN(j) (((DBG_MASK) >> (j)) & 1)

__global__ void __launch_bounds__(512, 2) fwd(Args args) {
    extern __shared__ __attribute__((aligned(16))) unsigned char lds_raw[];
    LAS unsigned char* lds = (LAS unsigned char*)lds_raw;
    volatile LAS unsigned* MISC = (volatile LAS unsigned*)(lds + MISC_OFF);
    if (threadIdx.x < 64) MISC[threadIdx.x] = 0u;
    __syncthreads();
    const int lo = args.ph_lo, hi = args.ph_hi;
    unsigned* barw = (unsigned*)(args.ws + WS_CTL) + CW_BAR + args.li * XCD_BAR_WORDS;
    XcdBarrier bar; bar.bar = barw; bar.x = 0; bar.st = MISC + 8;
    if (hi - lo > 1) bar = xcd_barrier_post(barw, MISC + 8);
#define IN(k) (lo <= (k) && (k) < hi)
#define SEAM(k) do { if (IN(k) && IN((k) + 1)) xcd_barrier(bar); } while (0)

    if (PHEN(0) && IN(0)) phase_prologue(lds);
    SEAM(0);
    for (int l = 0; l < 2; ++l) {
        const int pb = 1 + NPL * l;
        if (PHEN(1) && IN(pb + 0)) phase_inproj(lds, l);
        SEAM(pb + 0);
        if (PHEN(2) && IN(pb + 1)) phase_gate(lds, l);
        SEAM(pb + 1);
        if (PHEN(3) && IN(pb + 2)) phase_attn_tiles(lds, l);
        SEAM(pb + 2);
        if (PHEN(4) && IN(pb + 3)) phase_attn_combine(lds, l);
        SEAM(pb + 3);
        if (PHEN(5) && IN(pb + 4)) phase_outproj(lds, l);
        SEAM(pb + 4);
        if (PHEN(6) && IN(pb + 5)) phase_memq(lds, l);
        SEAM(pb + 5);
        if (PHEN(7) && IN(pb + 6)) phase_cross(lds, l);
        SEAM(pb + 6);
        if (PHEN(8) && IN(pb + 7)) phase_memo(lds, l);
        SEAM(pb + 7);
        if (PHEN(9) && IN(pb + 8)) phase_router(lds, l);
        SEAM(pb + 8);
        if (PHEN(10) && IN(pb + 9)) phase_scatter(lds, l);
        SEAM(pb + 9);
        if (PHEN(11) && IN(pb + 10)) phase_moe_a(lds, l);
        SEAM(pb + 10);
        if (PHEN(12) && IN(pb + 11)) phase_moe_b(lds, l);
        SEAM(pb + 11);
        if (PHEN(13) && IN(pb + 12)) phase_moe_c(lds, l);
        SEAM(pb + 12);
        if (PHEN(14) && IN(pb + 13)) phase_combine(lds, l);
        SEAM(pb + 13);
    }
#undef IN
#undef SEAM
}

extern "C" void kernel_launch(void* const* d_in, const int* in_sizes, int n_in, void* d_out, int out_size, void* d_ws, size_t ws_size, hipStream_t stream) {
    static int grid = 0;
    if (grid == 0) {
        if (n_in != N_IN || in_sizes[0] != T * D || out_size != T * D || ws_size < WS_END) { fprintf(stderr, "kernel_launch: unexpected shapes (n_in %d in0 %d out %d ws %zu need %zu)\n", n_in, n_in > 0 ? in_sizes[0] : -1, out_size, ws_size, (size_t)WS_END); grid = -1; return; }
        int dev = 0, cus = 0, per_cu = 0;
        if (hipGetDevice(&dev) != hipSuccess || hipDeviceGetAttribute(&cus, hipDeviceAttributeMultiprocessorCount, dev) != hipSuccess) { grid = -1; return; }
        if (hipFuncSetAttribute((const void*)fwd, hipFuncAttributeMaxDynamicSharedMemorySize, LDS_BYTES) != hipSuccess) { fprintf(stderr, "kernel_launch: hipFuncSetAttribute failed\n"); grid = -1; return; }
        if (hipOccupancyMaxActiveBlocksPerMultiprocessor(&per_cu, (const void*)fwd, 512, LDS_BYTES) != hipSuccess || per_cu < 1) fprintf(stderr, "kernel_launch: occupancy query reports %d\n", per_cu);
        (void)hipGetLastError();
        grid = cus;
    }
    if (grid < 0) return;
    if (hipMemsetAsync((char*)d_ws + WS_CTL, 0, CTL_ZERO_BYTES, stream) != hipSuccess) { fprintf(stderr, "kernel_launch: memset failed\n"); return; }
    Args a{};
    for (int i = 0; i < N_IN; ++i) a.in[i] = (const float*)d_in[i];
    a.out = (float*)d_out; a.ws = (unsigned char*)d_ws; a.pad = 0;
#if MK_LAUNCH_PER_PHASE
    for (int ph = 0; ph < NPH; ++ph) { a.ph_lo = ph; a.ph_hi = ph + 1; a.li = 0;
        hipLaunchKernelGGL(fwd, dim3(grid), dim3(512), LDS_BYTES, stream, a);
        const hipError_t le = hipPeekAtLastError(); if (le != hipSuccess) { fprintf(stderr, "kernel_launch: launch %d failed: %s\n", ph, hipGetErrorName(le)); break; } }
#else
    a.ph_lo = 0; a.ph_hi = NPH; a.li = 0;
    hipLaunchKernelGGL(fwd, dim3(grid), dim3(512), LDS_BYTES, stream, a);
    const hipError_t le = hipPeekAtLastError(); if (le != hipSuccess) fprintf(stderr, "kernel_launch: launch failed: %s\n", hipGetErrorName(le));
#endif
}
```
